# Optimizing an MI355X kernel written in HIP

```python
import jax, jax.numpy as jnp
from jax import lax
import numpy as np

D_MODEL = 2048
BATCH = 1
SEQ = 8192
DEPTH = 4

GRID_W = 64
CTX_LEN = 256

N_BRANCH = 4
BRANCH_W = 512
HEAD_DIM = 64
NA_HEADS = BRANCH_W // HEAD_DIM
NA_WIN_ROWS = 8
NA_WIN_COLS = 16
POOL_SIZES = (2, 4, 8, 16)
POOL_GROUP = BRANCH_W // len(POOL_SIZES)
GQA_Q_HEADS = BRANCH_W // HEAD_DIM
GQA_KV_HEADS = 2
Q_BLOCK = 128
ROPE_THETA = 10000.0
CONV_WIDTH = 31
EPS = 1e-6

PROJ_PARTS = (
    ("a_k", BRANCH_W), ("a_v", BRANCH_W),
    ("c_k", GQA_KV_HEADS * HEAD_DIM), ("c_v", GQA_KV_HEADS * HEAD_DIM),
    ("a_q", BRANCH_W), ("c_q", BRANCH_W),
    ("a_gate", BRANCH_W), ("b_in", BRANCH_W), ("b_gate", BRANCH_W),
    ("c_gate", BRANCH_W), ("d_glu", 2 * BRANCH_W), ("d_gate", BRANCH_W),
    ("merge", N_BRANCH * D_MODEL),
)
KV_COLS = 2 * BRANCH_W + 2 * GQA_KV_HEADS * HEAD_DIM
IN_COLS = sum(w for _, w in PROJ_PARTS)

kernel_name = "hybrid_parallel_gated_diffusion_block"


def split_proj(p):
    out = {}
    off = 0
    for name, w in PROJ_PARTS:
        if off + w > p.shape[-1]:
            break
        out[name] = p[..., off:off + w]
        off += w
    return out


def rms_norm(x, g):
    xf = x.astype(jnp.float32)
    y = xf * lax.rsqrt(jnp.mean(xf * xf, axis=-1, keepdims=True) + EPS)
    return (y * g).astype(x.dtype)


def layer_norm(x, g, b):
    xf = x.astype(jnp.float32)
    mu = jnp.mean(xf, axis=-1, keepdims=True)
    var = jnp.mean(jnp.square(xf - mu), axis=-1, keepdims=True)
    return ((xf - mu) * lax.rsqrt(var + EPS) * g + b).astype(x.dtype)


def modulate(x, g, shift, scale):
    return rms_norm(x, g) * (1 + scale) + shift


def _rope_axis(x, pos):
    half = x.shape[-1] // 2
    freqs = ROPE_THETA ** (-jnp.arange(half, dtype=jnp.float32) / half)
    ang = pos.astype(jnp.float32)[:, None] * freqs[None, :]
    cos = jnp.cos(ang)[:, None, :]
    sin = jnp.sin(ang)[:, None, :]
    xf = x.astype(jnp.float32)
    x1, x2 = xf[..., :half], xf[..., half:]
    return jnp.concatenate([x1 * cos - x2 * sin, x2 * cos + x1 * sin], axis=-1).astype(x.dtype)


def rope_2d(x, rows, cols):
    a = x.shape[-1] // 2
    return jnp.concatenate([_rope_axis(x[..., :a], rows), _rope_axis(x[..., a:], cols)], axis=-1)


def neighbourhood_attention(q, k, v, k_ctx, v_ctx, rpb):
    B, S, H, hd = q.shape
    R = S // GRID_W
    wr = min(NA_WIN_ROWS, R)
    r = jnp.arange(R)
    row_start = jnp.clip(r - wr // 2, 0, R - wr)
    band_rows = row_start[:, None] + jnp.arange(wr)[None, :]
    cq = jnp.arange(GRID_W)
    col_start = jnp.clip(cq - NA_WIN_COLS // 2, 0, GRID_W - NA_WIN_COLS)
    kc = jnp.arange(GRID_W)
    col_ok = (kc[None, :] >= col_start[:, None]) & (kc[None, :] < col_start[:, None] + NA_WIN_COLS)
    row_off = band_rows - r[:, None] + (NA_WIN_ROWS - 1)
    col_off = jnp.clip(kc[None, :] - cq[:, None], -(NA_WIN_COLS - 1), NA_WIN_COLS - 1) + (NA_WIN_COLS - 1)
    bias = rpb[:, row_off[:, None, :, None], col_off[None, :, None, :]].astype(jnp.float32)
    bias = jnp.where(col_ok[None, None, :, None, :], bias, -jnp.inf)
    scale = hd ** -0.5
    qg = q.reshape(B, R, GRID_W, H, hd)
    kg = k.reshape(B, R, GRID_W, H, hd)[:, band_rows]
    vg = v.reshape(B, R, GRID_W, H, hd)[:, band_rows]
    s_band = jnp.einsum('brqhd,brjkhd->bhrqjk', qg, kg).astype(jnp.float32) * scale + bias[None]
    s_ctx = jnp.einsum('brqhd,bchd->bhrqc', qg, k_ctx).astype(jnp.float32) * scale
    nb = wr * GRID_W
    s = jnp.concatenate([s_band.reshape(B, H, R, GRID_W, nb), s_ctx], axis=-1)
    p = jax.nn.softmax(s, axis=-1).astype(v.dtype)
    p_band = p[..., :nb].reshape(B, H, R, GRID_W, wr, GRID_W)
    p_ctx = p[..., nb:]
    o = jnp.einsum('bhrqjk,brjkhd->brqhd', p_band, vg) + jnp.einsum('bhrqc,bchd->brqhd', p_ctx, v_ctx)
    return o.reshape(B, S, H, hd)


def dense_attention(q, k, v):
    B, L, Hq, hd = q.shape
    Hk = k.shape[2]
    qg = q.reshape(B, L, Hk, Hq // Hk, hd)
    s = jnp.einsum('bqkgd,bnkd->bkgqn', qg, k).astype(jnp.float32) * (hd ** -0.5)
    p = jax.nn.softmax(s, axis=-1).astype(v.dtype)
    return jnp.einsum('bkgqn,bnkd->bqkgd', p, v).reshape(B, L, Hq, hd)


def gqa_latent_attention(q, k, v, k_ctx, v_ctx):
    B, S, Hq, hd = q.shape
    k_all = jnp.concatenate([k, k_ctx], axis=1)
    v_all = jnp.concatenate([v, v_ctx], axis=1)
    nblk = S // Q_BLOCK
    qb = jnp.moveaxis(q.reshape(B, nblk, Q_BLOCK, Hq, hd), 1, 0)
    o = lax.map(lambda qi: dense_attention(qi, k_all, v_all), qb)
    return jnp.moveaxis(o, 0, 1).reshape(B, S, Hq, hd)


def multiscale_pool(u, w_pool, pool_scale):
    B, L, W = u.shape
    uf = u.astype(jnp.float32)
    csum = jnp.concatenate([jnp.zeros((B, 1, W), jnp.float32), jnp.cumsum(uf, axis=1)], axis=1)
    t = jnp.arange(L)
    outs = []
    for gi, ksz in enumerate(POOL_SIZES):
        sl = slice(gi * POOL_GROUP, (gi + 1) * POOL_GROUP)
        lo = jnp.clip(t - ksz // 2, 0, L - 1)
        hi = jnp.clip(t + ksz - 1 - ksz // 2, 0, L - 1)
        cg = csum[..., sl]
        mean = (cg[:, hi + 1] - cg[:, lo]) / (hi - lo + 1).astype(jnp.float32)[None, :, None]
        d = (mean - uf[..., sl]).astype(u.dtype)
        outs.append(d @ w_pool[gi])
    return jnp.concatenate(outs, axis=-1) * pool_scale


def conformer_conv(glu_in, conv_w, conv_b, ln_g, ln_b, w_pw):
    a, g = jnp.split(glu_in, 2, axis=-1)
    u = a * jax.nn.sigmoid(g)
    y = lax.conv_general_dilated(
        u, conv_w[:, None, :].astype(u.dtype), window_strides=(1,),
        padding=((CONV_WIDTH // 2, CONV_WIDTH // 2),),
        dimension_numbers=('NWC', 'WIO', 'NWC'), feature_group_count=BRANCH_W) + conv_b
    y = jax.nn.silu(layer_norm(y, ln_g, ln_b))
    return y @ w_pw


def branch_merge(p, o_a, o_b, o_c, o_d, w_branch, w_out):
    outs = (o_a * jax.nn.silu(p['a_gate']), o_b * jax.nn.silu(p['b_gate']),
            o_c * jax.nn.silu(p['c_gate']), o_d * jax.nn.silu(p['d_gate']))
    gates = jax.nn.sigmoid(p['merge'])
    y = 0
    for bi in range(N_BRANCH):
        y = y + gates[..., bi * D_MODEL:(bi + 1) * D_MODEL] * (outs[bi] @ w_branch[bi])
    return y @ w_out


def setup_inputs(seed: int = 0) -> dict:
    key = jax.random.key(seed)
    ks = jax.random.split(key, 24)
    f = jnp.float32
    nrm = lambda k, shape, s: jax.random.normal(k, shape, f) * s
    return {
        "x": nrm(ks[0], (BATCH, SEQ, D_MODEL), 1.0),
        "c": nrm(ks[1], (BATCH, D_MODEL), 1.0),
        "ctx": nrm(ks[2], (BATCH, CTX_LEN, D_MODEL), 1.0),
        "c_ctx": nrm(ks[3], (D_MODEL,), 1.0),
        "w_ada": nrm(ks[4], (DEPTH, D_MODEL, 3 * D_MODEL), D_MODEL ** -0.5),
        "b_ada": nrm(ks[5], (DEPTH, 3 * D_MODEL), 0.01),
        "g_pre": 1.0 + nrm(ks[6], (DEPTH, D_MODEL), 0.05),
        "g_post": 1.0 + nrm(ks[7], (DEPTH, D_MODEL), 0.05),
        "w_in": nrm(ks[8], (DEPTH, D_MODEL, IN_COLS), D_MODEL ** -0.5),
        "na_rpb": nrm(ks[9], (DEPTH, NA_HEADS, 2 * NA_WIN_ROWS - 1, 2 * NA_WIN_COLS - 1), 0.1),
        "pool_w": nrm(ks[10], (DEPTH, len(POOL_SIZES), POOL_GROUP, POOL_GROUP), POOL_GROUP ** -0.5),
        "pool_scale": 1.0 + nrm(ks[11], (DEPTH, BRANCH_W), 0.1),
        "q_norm": 1.0 + nrm(ks[12], (DEPTH, HEAD_DIM), 0.05),
        "k_norm": 1.0 + nrm(ks[13], (DEPTH, HEAD_DIM), 0.05),
        "conv_w": nrm(ks[14], (DEPTH, CONV_WIDTH, BRANCH_W), CONV_WIDTH ** -0.5),
        "conv_b": nrm(ks[15], (DEPTH, BRANCH_W), 0.01),
        "conv_ln_g": 1.0 + nrm(ks[16], (DEPTH, BRANCH_W), 0.05),
        "conv_ln_b": nrm(ks[17], (DEPTH, BRANCH_W), 0.01),
        "conv_pw": nrm(ks[18], (DEPTH, BRANCH_W, BRANCH_W), BRANCH_W ** -0.5),
        "w_branch": nrm(ks[19], (DEPTH, N_BRANCH, BRANCH_W, D_MODEL), BRANCH_W ** -0.5),
        "w_out": nrm(ks[20], (DEPTH, D_MODEL, D_MODEL), D_MODEL ** -0.5),
    }


def reference(x, c, ctx, c_ctx, w_ada, b_ada, g_pre, g_post, w_in, na_rpb, pool_w, pool_scale,
              q_norm, k_norm, conv_w, conv_b, conv_ln_g, conv_ln_b, conv_pw, w_branch, w_out):
    B, S, _ = x.shape
    Cn = ctx.shape[1]
    t = jnp.arange(S)
    rows = t // GRID_W
    cols = t % GRID_W
    hd = HEAD_DIM
    for l in range(DEPTH):
        last = l == DEPTH - 1
        shift, scale, gate = jnp.split(jax.nn.silu(c) @ w_ada[l] + b_ada[l], 3, axis=-1)
        shift_c, scale_c, gate_c = jnp.split(jax.nn.silu(c_ctx) @ w_ada[l] + b_ada[l], 3, axis=-1)
        h = modulate(x, g_pre[l], shift[:, None], scale[:, None])
        hc = modulate(ctx, g_pre[l], shift_c, scale_c)
        p = split_proj(h @ w_in[l])
        pc = split_proj(hc @ (w_in[l, :, :KV_COLS] if last else w_in[l]))
        ka_c = pc['a_k'].reshape(B, Cn, NA_HEADS, hd)
        va_c = pc['a_v'].reshape(B, Cn, NA_HEADS, hd)
        kc_c = rms_norm(pc['c_k'].reshape(B, Cn, GQA_KV_HEADS, hd), k_norm[l])
        vc_c = pc['c_v'].reshape(B, Cn, GQA_KV_HEADS, hd)
        o_a = neighbourhood_attention(p['a_q'].reshape(B, S, NA_HEADS, hd), p['a_k'].reshape(B, S, NA_HEADS, hd),
                                      p['a_v'].reshape(B, S, NA_HEADS, hd), ka_c, va_c, na_rpb[l])
        o_b = multiscale_pool(p['b_in'], pool_w[l], pool_scale[l])
        qc = rope_2d(rms_norm(p['c_q'].reshape(B, S, GQA_Q_HEADS, hd), q_norm[l]), rows, cols)
        kc = rope_2d(rms_norm(p['c_k'].reshape(B, S, GQA_KV_HEADS, hd), k_norm[l]), rows, cols)
        vc = p['c_v'].reshape(B, S, GQA_KV_HEADS, hd)
        o_c = gqa_latent_attention(qc, kc, vc, kc_c, vc_c)
        o_d = conformer_conv(p['d_glu'], conv_w[l], conv_b[l], conv_ln_g[l], conv_ln_b[l], conv_pw[l])
        y = branch_merge(p, o_a.reshape(B, S, BRANCH_W), o_b, o_c.reshape(B, S, BRANCH_W), o_d,
                         w_branch[l], w_out[l])
        x_next = x + gate[:, None] * rms_norm(y, g_post[l])
        if not last:
            o_a_c = dense_attention(pc['a_q'].reshape(B, Cn, NA_HEADS, hd), ka_c, va_c)
            o_b_c = multiscale_pool(pc['b_in'], pool_w[l], pool_scale[l])
            qc_c = rms_norm(pc['c_q'].reshape(B, Cn, GQA_Q_HEADS, hd), q_norm[l])
            o_c_c = dense_attention(qc_c, kc_c, vc_c)
            o_d_c = conformer_conv(pc['d_glu'], conv_w[l], conv_b[l], conv_ln_g[l], conv_ln_b[l], conv_pw[l])
            y_c = branch_merge(pc, o_a_c.reshape(B, Cn, BRANCH_W), o_b_c, o_c_c.reshape(B, Cn, BRANCH_W),
                               o_d_c, w_branch[l], w_out[l])
            ctx = ctx + gate_c * rms_norm(y_c, g_post[l])
        x = x_next
    return x
```

```cpp
#include <hip/hip_runtime.h>
#include <hip/hip_cooperative_groups.h>
#include <cstdio>
#include <cstdint>
namespace cg = cooperative_groups;

#define LAS __attribute__((address_space(3)))
typedef unsigned short bf16_t;
typedef short bf16x8 __attribute__((ext_vector_type(8)));
typedef float f32x4 __attribute__((ext_vector_type(4)));
typedef float f32x16 __attribute__((ext_vector_type(16)));
typedef unsigned u32x4 __attribute__((ext_vector_type(4)));
typedef unsigned u32x2 __attribute__((ext_vector_type(2)));

constexpr int DM = 2048, SEQ = 8192, NCTX = 256, MT = SEQ + NCTX, DEPTH = 4, INC = 14080;
constexpr int A_K = 0, A_V = 512, C_K = 1024, C_V = 1152, A_Q = 1280, C_Q = 1792, A_G = 2304, B_IN = 2816, B_G = 3328, C_G = 3840, D_GLU = 4352, D_G = 5376, MERGE = 5888;
constexpr float EPS = 1e-6f, LOG2E = 1.4426950408889634f, QS = 0.125f * 1.4426950408889634f;

constexpr size_t al256(size_t x) { return (x + 255) & ~(size_t)255; }
constexpr size_t WS_WIN = 0;
constexpr size_t WS_WBR = al256(WS_WIN + (size_t)DEPTH * INC * DM * 2);
constexpr size_t WS_WOUT = al256(WS_WBR + (size_t)DEPTH * DM * DM * 2);
constexpr size_t WS_WPW = al256(WS_WOUT + (size_t)DEPTH * DM * DM * 2);
constexpr size_t WS_WPOOL = WS_WPW + (size_t)DEPTH * 512 * 512 * 2;
constexpr size_t WS_MOD = al256(WS_WPOOL + (size_t)DEPTH * 512 * 512 * 2);
constexpr size_t WS_ROPE = al256(WS_MOD + (size_t)DEPTH * 2 * 6144 * 4);
constexpr size_t WS_H = al256(WS_ROPE + 2 * 128 * 16 * 4);
constexpr size_t WS_P = al256(WS_H + (size_t)MT * DM * 2);
constexpr size_t WS_QALL = al256(WS_P + (size_t)MT * INC * 2);
constexpr size_t WS_KC = al256(WS_QALL + (size_t)MT * 1024 * 2);
constexpr size_t WS_VT = al256(WS_KC + (size_t)MT * 128 * 2);
constexpr size_t WS_DLN = al256(WS_VT + (size_t)10 * 64 * MT * 2);
constexpr size_t WS_DP = WS_DLN + (size_t)MT * 512 * 2;
constexpr size_t WS_O = al256(WS_DP + (size_t)MT * 512 * 2);
constexpr size_t WS_YACC = al256(WS_O + (size_t)MT * DM * 2);
constexpr size_t WS_Y1 = al256(WS_YACC + (size_t)MT * DM * 4);
constexpr size_t WS_Y = al256(WS_Y1 + (size_t)MT * DM * 2);
constexpr size_t WS_X = al256(WS_Y + (size_t)MT * DM * 4);
constexpr size_t WS_CTL = al256(WS_X + (size_t)MT * DM * 4);
constexpr size_t WS_END = WS_CTL + 8192;

constexpr int LDS_BYTES = 131072;
#define N_LAUNCH_MODE 1
#define ZERO_LO WS_H
#define ZERO_HI WS_CTL

struct Params {
    const float *x, *c, *ctx, *c_ctx, *w_ada, *b_ada, *g_pre, *g_post, *w_in, *na_rpb, *pool_w, *pool_scale, *q_norm, *k_norm, *conv_w, *conv_b, *conv_ln_g, *conv_ln_b, *conv_pw, *w_branch, *w_out;
    float* out; unsigned char* ws;
};

__device__ __forceinline__ float bf2f(bf16_t b) { return __uint_as_float(((unsigned)b) << 16); }
__device__ __forceinline__ unsigned cvt_pk_bf16(float lo, float hi) { unsigned r; asm volatile("v_cvt_pk_bf16_f32 %0, %1, %2" : "=v"(r) : "v"(lo), "v"(hi)); return r; }
__device__ __forceinline__ bf16_t f2bf(float f) { return (bf16_t)(cvt_pk_bf16(f, 0.f) & 0xffffu); }
__device__ __forceinline__ float fexp2(float x) { return __builtin_amdgcn_exp2f(x); }
__device__ __forceinline__ float sigmoidf_(float x) { return __builtin_amdgcn_rcpf(1.0f + fexp2(-x * LOG2E)); }
__device__ __forceinline__ float siluf_(float x) { return x * sigmoidf_(x); }
__device__ __forceinline__ float wave_sum(float v) { v += __shfl_xor(v, 32); v += __shfl_xor(v, 16); v += __shfl_xor(v, 8); v += __shfl_xor(v, 4); v += __shfl_xor(v, 2); v += __shfl_xor(v, 1); return v; }
__device__ __forceinline__ float lo_bf(unsigned w) { return __uint_as_float(w << 16); }
__device__ __forceinline__ float hi_bf(unsigned w) { return __uint_as_float(w & 0xffff0000u); }
__device__ __forceinline__ f32x4 ld4bf(const bf16_t* q) { const u32x2 w = *(const u32x2*)q; return (f32x4){lo_bf(w.x), hi_bf(w.x), lo_bf(w.y), hi_bf(w.y)}; }
__device__ __forceinline__ int clampi(int v, int lo, int hi) { return v < lo ? lo : (v > hi ? hi : v); }
__device__ __forceinline__ int opaque_tid() { int t = threadIdx.x; asm volatile("" : "+v"(t)); return t; }
__device__ __forceinline__ int opaque_s(int v) { asm volatile("" : "+s"(v)); return v; }

namespace pg8 {
constexpr int BM = 256, BK = 64, HALF = 128, HTB = HALF * BK * 2, STAGE_BYTES = 8 * HTB, NXCD = 8, WGM = 8;
__host__ __device__ __forceinline__ int lds_byte(int r, int c) { const int st = (r >> 4) * 2 + (c >> 5), rr = r & 15, cc = c & 31, ob = rr * 64 + cc * 2; return st * 1024 + (ob ^ (((ob >> 9) & 1) << 5)); }
__host__ __device__ __forceinline__ void stage_rc(int b, int& R, int& C) { const int st = b / 1024, sb = b % 1024, swz = sb ^ (((sb >> 9) & 1) << 5); R = (st >> 1) * 16 + swz / 64; C = (st & 1) * 32 + (swz % 64) / 2; }
__host__ __device__ __forceinline__ int perm32(int rho) { const int n = rho >> 4, i = rho & 15; return 8 * (i >> 2) + 4 * n + (i & 3); }

struct Unit { int pm, pn, tag; };
struct Gemm { const bf16_t* A; const bf16_t* Bt; int lda, ldb, K; size_t a_tag, b_tag; };

struct StaticOrder {
    int nM, nN, nwg, G, c, extra;
    __device__ void init(int M, int N, int G_, int c_, int extra_ = 0) { nM = M / BM; nN = N / BM; nwg = nM * nN; G = G_; c = c_; extra = extra_; }
    __device__ bool tile(long L, Unit& u) const {
        if (L >= nwg) { if (L >= nwg + extra) return false; u.pm = nM; u.pn = (int)(L - nwg); u.tag = 0; return true; }
        int wgid = (int)L; { const int q = nwg / NXCD, r = nwg % NXCD, xcd = wgid % NXCD, off = wgid / NXCD; wgid = (xcd < r ? xcd * (q + 1) : r * (q + 1) + (xcd - r) * q) + off; }
        const int nig = WGM * nN, gid = wgid / nig, fm = gid * WGM, gsz = (nM - fm) < WGM ? (nM - fm) : WGM;
        u.pm = fm + ((wgid % nig) % gsz); u.pn = (wgid % nig) / gsz; u.tag = 0; return true;
    }
    __device__ bool next(int i, Unit& u) const { return tile((long)i * G + c, u); }
};
template <int NT> struct TagOrder : StaticOrder {
    __device__ bool next(int i, Unit& u) const { if (!tile((long)(i / NT) * G + c, u)) return false; u.tag = i % NT; return true; }
};
struct SmallOrder {
    int G, c;
    __device__ bool next(int i, Unit& u) const { const int L = i * G + c; if (L >= 132) return false; u.tag = L / 66; const int rem = L % 66; u.pm = rem >> 1; u.pn = rem & 1; return true; }
};

template <class Epi, class Sched>
__device__ __forceinline__ void gemm_phase(LAS unsigned char* lds, const Gemm g, const Sched& S, const Epi& E) {
    const int tid = opaque_tid(), wid = __builtin_amdgcn_readfirstlane(tid >> 6), lane = tid & 63, wr = wid >> 2, wc = wid & 3, fr = lane & 15, fq = lane >> 4;
    const int nt = g.K / BK;
    unsigned voffA[2], voffB[2];
#pragma unroll
    for (int i = 0; i < 2; ++i) { int R, C; stage_rc(tid * 16 + i * 8192, R, C); const int Rb = Epi::PERM ? ((R & ~31) + perm32(R & 31)) : R;
        voffA[i] = (unsigned)(R * g.lda + C) * 2u; voffB[i] = (unsigned)(Rb * g.ldb + C) * 2u; }
    const size_t kstep = (size_t)(BK * 2);
    const size_t hstepA = (size_t)HALF * g.lda * 2, hstepB = (size_t)HALF * g.ldb * 2;
    const unsigned ldsw = (unsigned)wid * 1024u;
    const int aoff = lds_byte(wr * 64 + fr, fq * 8), boff = lds_byte(wc * 32 + fr, fq * 8);
#define PG8_UA(u) ((const char*)g.A + ((size_t)(u).pm * BM * g.lda + (size_t)(u).tag * g.a_tag) * 2)
#define PG8_UB(u) ((const char*)g.Bt + ((size_t)(u).pn * BM * g.ldb + (size_t)(u).tag * g.b_tag) * 2)
#define PG8_SA(b, h) (((b) * 2 + (h)) * HTB)
#define PG8_SB(b, h) ((4 + (b) * 2 + (h)) * HTB)
#define PG8_STAGE(bufoff, gbase, voff) do { _Pragma("unroll") for (int _i = 0; _i < 2; ++_i) \
        __builtin_amdgcn_global_load_lds((const unsigned*)((const char*)(gbase) + (voff)[_i]), (LAS unsigned*)(lds + (bufoff) + ldsw + _i * 8192), 16, 0, 0); } while (0)
#define PG8_LDA(dst, b, h) do { _Pragma("unroll") for (int m = 0; m < 4; ++m) _Pragma("unroll") for (int k = 0; k < 2; ++k) dst[m][k] = *(const LAS bf16x8*)(lds + PG8_SA(b, h) + aoff + m * 2048 + k * 1024); } while (0)
#define PG8_LDB(dst, b, h) do { _Pragma("unroll") for (int n = 0; n < 2; ++n) _Pragma("unroll") for (int k = 0; k < 2; ++k) dst[n][k] = *(const LAS bf16x8*)(lds + PG8_SB(b, h) + boff + n * 2048 + k * 1024); } while (0)
#define PG8_MMA(ai, bj, At, Bt) do { __builtin_amdgcn_s_setprio(1); _Pragma("unroll") for (int m = 0; m < 4; ++m) _Pragma("unroll") for (int n = 0; n < 2; ++n) _Pragma("unroll") for (int k = 0; k < 2; ++k) \
        acc[ai][bj][m][n] = __builtin_amdgcn_mfma_f32_16x16x32_bf16(Bt[n][k], At[m][k], acc[ai][bj][m][n], 0, 0, 0); __builtin_amdgcn_s_setprio(0); } while (0)
#define PG8_WAIT_V(n) asm volatile("s_waitcnt vmcnt(" #n ")" ::: "memory")
#define PG8_WAIT_L(n) asm volatile("s_waitcnt lgkmcnt(" #n ")" ::: "memory")
#define PG8_BAR __builtin_amdgcn_s_barrier()
#define PG8_SCHED __builtin_amdgcn_sched_barrier(0)
    Unit cur, nxt; int ui = 0;
    if (!S.next(0, cur)) return;
    f32x4 acc[2][2][4][2];
#pragma unroll
    for (int a = 0; a < 2; ++a)
#pragma unroll
        for (int b = 0; b < 2; ++b)
#pragma unroll
            for (int m = 0; m < 4; ++m)
#pragma unroll
                for (int n = 0; n < 2; ++n) acc[a][b][m][n] = (f32x4){0.f, 0.f, 0.f, 0.f};
    bf16x8 At[4][2], B0[2][2], B1[2][2];
    const char* cA = PG8_UA(cur); const char* cB = PG8_UB(cur);
    PG8_STAGE(PG8_SB(0, 0), cB, voffB); PG8_STAGE(PG8_SB(0, 1), cB + hstepB, voffB); PG8_STAGE(PG8_SA(0, 0), cA, voffA); PG8_STAGE(PG8_SA(0, 1), cA + hstepA, voffA);
    if (wr == 1) PG8_BAR;
    PG8_WAIT_V(2); PG8_BAR;
    PG8_STAGE(PG8_SB(1, 0), cB + kstep, voffB); PG8_STAGE(PG8_SA(1, 0), cA + kstep, voffA); PG8_STAGE(PG8_SB(1, 1), cB + hstepB + kstep, voffB);
    PG8_WAIT_V(6); PG8_BAR;
    for (;;) {
        const bool has_next = S.next(ui + 1, nxt);
        const char* nA = has_next ? PG8_UA(nxt) : cA; const char* nB = has_next ? PG8_UB(nxt) : cB;
        for (int t = 0; t < nt; t += 2) {
            const bool last = (t == nt - 2);
            const char* a1 = cA + (size_t)(t + 1) * kstep;
            const char* a2 = last ? nA : cA + (size_t)(t + 2) * kstep; const char* b2 = last ? nB : cB + (size_t)(t + 2) * kstep;
            const char* a3 = a2 + kstep; const char* b3 = b2 + kstep;
            PG8_LDB(B0, 0, 0); PG8_LDB(B1, 0, 1); PG8_SCHED; PG8_LDA(At, 0, 0); PG8_STAGE(PG8_SA(1, 1), a1 + hstepA, voffA);
            PG8_WAIT_V(8); PG8_WAIT_L(0); PG8_BAR; PG8_MMA(0, 0, At, B0); PG8_MMA(0, 1, At, B1); PG8_BAR; PG8_SCHED;
            PG8_LDA(At, 0, 1); PG8_STAGE(PG8_SB(0, 0), b2, voffB); PG8_STAGE(PG8_SB(0, 1), b2 + hstepB, voffB); PG8_STAGE(PG8_SA(0, 0), a2, voffA);
            PG8_WAIT_V(8); PG8_WAIT_L(0); PG8_BAR; PG8_MMA(1, 0, At, B0); PG8_MMA(1, 1, At, B1); PG8_BAR; PG8_SCHED;
            PG8_LDB(B0, 1, 0); PG8_LDB(B1, 1, 1); PG8_SCHED; PG8_LDA(At, 1, 0); PG8_STAGE(PG8_SA(0, 1), a2 + hstepA, voffA);
            PG8_WAIT_V(8); PG8_WAIT_L(0); PG8_BAR; PG8_MMA(0, 0, At, B0); PG8_MMA(0, 1, At, B1); PG8_BAR; PG8_SCHED;
            PG8_LDA(At, 1, 1); PG8_STAGE(PG8_SB(1, 0), b3, voffB); PG8_STAGE(PG8_SB(1, 1), b3 + hstepB, voffB); PG8_STAGE(PG8_SA(1, 0), a3, voffA);
            PG8_WAIT_V(8); PG8_WAIT_L(0); PG8_BAR; PG8_MMA(1, 0, At, B0); PG8_MMA(1, 1, At, B1); PG8_BAR; PG8_SCHED;
        }
        if (wr == 0) PG8_BAR;
        E(acc, cur, wr, wc, fr, fq);
        if (!has_next) break;
        if (!(Epi::CHAIN && cur.tag != Epi::LAST_TAG)) {
#pragma unroll
        for (int a = 0; a < 2; ++a)
#pragma unroll
            for (int b = 0; b < 2; ++b)
#pragma unroll
                for (int m = 0; m < 4; ++m)
#pragma unroll
                    for (int n = 0; n < 2; ++n) acc[a][b][m][n] = (f32x4){0.f, 0.f, 0.f, 0.f};
        }
        cur = nxt; cA = nA; cB = nB; ++ui;
        if (wr == 1) PG8_BAR;
    }
    PG8_WAIT_V(0);
    PG8_BAR;
#undef PG8_UA
#undef PG8_UB
#undef PG8_SA
#undef PG8_SB
#undef PG8_STAGE
#undef PG8_LDA
#undef PG8_LDB
#undef PG8_MMA
#undef PG8_WAIT_V
#undef PG8_WAIT_L
#undef PG8_BAR
#undef PG8_SCHED
}

struct EpiStoreBf16 {
    static constexpr bool PERM = true, CHAIN = false; static constexpr int LAST_TAG = 0;
    bf16_t* O; int ldc;
    __device__ __forceinline__ void operator()(const f32x4 (&acc)[2][2][4][2], const Unit& u, int wr, int wc, int fr, int fq) const {
        const int row0 = u.pm * BM + wr * 64 + fr, col0 = u.pn * BM + wc * 32 + 8 * fq;
#pragma unroll
        for (int ai = 0; ai < 2; ++ai)
#pragma unroll
            for (int m = 0; m < 4; ++m) { bf16_t* rowp = O + (size_t)(row0 + ai * HALF + m * 16) * ldc + col0;
#pragma unroll
                for (int bj = 0; bj < 2; ++bj) { const f32x4 v0 = acc[ai][bj][m][0], v1 = acc[ai][bj][m][1];
                    u32x4 w; w.x = cvt_pk_bf16(v0[0], v0[1]); w.y = cvt_pk_bf16(v0[2], v0[3]); w.z = cvt_pk_bf16(v1[0], v1[1]); w.w = cvt_pk_bf16(v1[2], v1[3]);
                    *(u32x4*)(rowp + bj * HALF) = w; } }
    }
};
struct EpiF32 {
    static constexpr bool PERM = false, CHAIN = false; static constexpr int LAST_TAG = 0;
    float* C; int ldc;
    __device__ __forceinline__ void operator()(const f32x4 (&acc)[2][2][4][2], const Unit& u, int wr, int wc, int fr, int fq) const {
        const int row0 = u.pm * BM + wr * 64 + fr, col0 = u.pn * BM + wc * 32 + 4 * fq;
#pragma unroll
        for (int ai = 0; ai < 2; ++ai)
#pragma unroll
            for (int m = 0; m < 4; ++m) { float* rowp = C + (size_t)(row0 + ai * HALF + m * 16) * ldc + col0;
#pragma unroll
                for (int bj = 0; bj < 2; ++bj)
#pragma unroll
                    for (int n = 0; n < 2; ++n) *(f32x4*)(rowp + bj * HALF + n * 16) = acc[ai][bj][m][n]; }
    }
};
struct EpiSmall {
    static constexpr bool PERM = true, CHAIN = false; static constexpr int LAST_TAG = 0;
    bf16_t* O; const bf16_t* P; const float* pool_scale;
    __device__ __forceinline__ void operator()(const f32x4 (&acc)[2][2][4][2], const Unit& u, int wr, int wc, int fr, int fq) const {
        const int row0 = u.pm * BM + wr * 64 + fr, col0 = u.pn * BM + wc * 32 + 8 * fq;
        const int gcol = u.tag ? B_G : D_G, ocol = u.tag ? 512 : 1536;
#pragma unroll
        for (int bj = 0; bj < 2; ++bj) {
            const int c = col0 + bj * HALF;
            f32x4 s0 = (f32x4){1.f, 1.f, 1.f, 1.f}, s1 = s0;
            if (u.tag) { s0 = *(const f32x4*)(pool_scale + c); s1 = *(const f32x4*)(pool_scale + c + 4); }
#pragma unroll
            for (int ai = 0; ai < 2; ++ai)
#pragma unroll
                for (int m = 0; m < 4; ++m) {
                    const size_t row = (size_t)(row0 + ai * HALF + m * 16);
                    const u32x4 gw = *(const u32x4*)(P + row * INC + gcol + c);
                    const f32x4 v0 = acc[ai][bj][m][0] * s0, v1 = acc[ai][bj][m][1] * s1;
                    u32x4 w;
                    w.x = cvt_pk_bf16(v0[0] * siluf_(lo_bf(gw.x)), v0[1] * siluf_(hi_bf(gw.x)));
                    w.y = cvt_pk_bf16(v0[2] * siluf_(lo_bf(gw.y)), v0[3] * siluf_(hi_bf(gw.y)));
                    w.z = cvt_pk_bf16(v1[0] * siluf_(lo_bf(gw.z)), v1[1] * siluf_(hi_bf(gw.z)));
                    w.w = cvt_pk_bf16(v1[2] * siluf_(lo_bf(gw.w)), v1[3] * siluf_(hi_bf(gw.w)));
                    *(u32x4*)(O + row * DM + ocol + c) = w;
                }
        }
    }
};
struct EpiMerge {
    static constexpr bool PERM = true, CHAIN = true; static constexpr int LAST_TAG = 3;
    bf16_t* Y1; const bf16_t* P;
    __device__ __forceinline__ void operator()(f32x4 (&acc)[2][2][4][2], const Unit& u, int wr, int wc, int fr, int fq) const {
        const int row0 = u.pm * BM + wr * 64 + fr, col0 = u.pn * BM + wc * 32 + 8 * fq;
        const int b = u.tag;
#pragma unroll
        for (int ai = 0; ai < 2; ++ai)
#pragma unroll
            for (int m = 0; m < 4; ++m) {
                const size_t row = (size_t)(row0 + ai * HALF + m * 16);
#pragma unroll
                for (int bj = 0; bj < 2; ++bj) {
                    const int c = col0 + bj * HALF;
                    const u32x4 gw = *(const u32x4*)(P + row * INC + MERGE + b * DM + c);
                    float eb[8] = {fexp2(-lo_bf(gw.x) * LOG2E), fexp2(-hi_bf(gw.x) * LOG2E), fexp2(-lo_bf(gw.y) * LOG2E), fexp2(-hi_bf(gw.y) * LOG2E),
                                   fexp2(-lo_bf(gw.z) * LOG2E), fexp2(-hi_bf(gw.z) * LOG2E), fexp2(-lo_bf(gw.w) * LOG2E), fexp2(-hi_bf(gw.w) * LOG2E)};
                    f32x4 v0 = acc[ai][bj][m][0], v1 = acc[ai][bj][m][1];
                    if (b != 3) {
                        const u32x4 gn = *(const u32x4*)(P + row * INC + MERGE + (b + 1) * DM + c);
                        float en[8] = {fexp2(-lo_bf(gn.x) * LOG2E), fexp2(-hi_bf(gn.x) * LOG2E), fexp2(-lo_bf(gn.y) * LOG2E), fexp2(-hi_bf(gn.y) * LOG2E),
                                       fexp2(-lo_bf(gn.z) * LOG2E), fexp2(-hi_bf(gn.z) * LOG2E), fexp2(-lo_bf(gn.w) * LOG2E), fexp2(-hi_bf(gn.w) * LOG2E)};
#pragma unroll
                        for (int e = 0; e < 4; ++e) { v0[e] *= (1.0f + en[e]) * __builtin_amdgcn_rcpf(1.0f + eb[e]); v1[e] *= (1.0f + en[4 + e]) * __builtin_amdgcn_rcpf(1.0f + eb[4 + e]); }
                        acc[ai][bj][m][0] = v0; acc[ai][bj][m][1] = v1;
                    } else {
#pragma unroll
                        for (int e = 0; e < 4; ++e) { v0[e] *= __builtin_amdgcn_rcpf(1.0f + eb[e]); v1[e] *= __builtin_amdgcn_rcpf(1.0f + eb[4 + e]); }
                        u32x4 w; w.x = cvt_pk_bf16(v0[0], v0[1]); w.y = cvt_pk_bf16(v0[2], v0[3]); w.z = cvt_pk_bf16(v1[0], v1[1]); w.w = cvt_pk_bf16(v1[2], v1[3]);
                        *(u32x4*)(Y1 + row * DM + c) = w;
                    }
                }
            }
    }
};
}

template <int NB>
__device__ __forceinline__ void transpose_load(f32x4 (&v)[2 * NB], const float* src, int sp, int tid) {
#pragma unroll
    for (int i = 0; i < 2 * NB; ++i) { const int idx = tid + i * 512, r = idx / (16 * NB), cc = idx % (16 * NB);
        v[i] = *(const f32x4*)(src + (size_t)r * sp + cc * 4); }
}
template <int NB>
__device__ __forceinline__ void transpose_store(LAS float* tile, const f32x4 (&v)[2 * NB], bf16_t* dst, int dp, int tid) {
#pragma unroll
    for (int i = 0; i < 2 * NB; ++i) { const int idx = tid + i * 512, r = idx / (16 * NB), cc = idx % (16 * NB), j = cc >> 4, c4 = cc & 15;
        LAS float* t = tile + j * (64 * 65) + r * 65 + c4 * 4; t[0] = v[i][0]; t[1] = v[i][1]; t[2] = v[i][2]; t[3] = v[i][3]; }
    __syncthreads();
    { const int c = tid >> 3, r8 = (tid & 7) * 8;
#pragma unroll
      for (int j = 0; j < NB; ++j) { float w8[8];
#pragma unroll
          for (int e = 0; e < 8; ++e) w8[e] = tile[j * (64 * 65) + (r8 + e) * 65 + c];
          u32x4 w; w.x = cvt_pk_bf16(w8[0], w8[1]); w.y = cvt_pk_bf16(w8[2], w8[3]); w.z = cvt_pk_bf16(w8[4], w8[5]); w.w = cvt_pk_bf16(w8[6], w8[7]);
          *(u32x4*)(dst + (size_t)(j * 64 + c) * dp + r8) = w; } }
    __syncthreads();
}
template <int NB>
__device__ __forceinline__ void transpose_batch(LAS float* tile, const float* src, int sp, bf16_t* dst, int dp, int tid) {
    f32x4 v[2 * NB]; transpose_load<NB>(v, src, sp, tid); transpose_store<NB>(tile, v, dst, dp, tid);
}

__device__ void phase0(const Params& p, LAS unsigned char* lds, int bid, int nb) {
    const int tid = opaque_tid();
    bf16_t* WIN = (bf16_t*)(p.ws + WS_WIN); bf16_t* WBR = (bf16_t*)(p.ws + WS_WBR); bf16_t* WOUT = (bf16_t*)(p.ws + WS_WOUT);
    bf16_t* WPW = (bf16_t*)(p.ws + WS_WPW); bf16_t* WPOOL = (bf16_t*)(p.ws + WS_WPOOL);
    float* MOD = (float*)(p.ws + WS_MOD); float* ROPE = (float*)(p.ws + WS_ROPE);
    for (int task = bid; task < 384; task += nb) {
        const int l = task / 96, j0 = (task % 96) * 64;
        LAS float* sv = (LAS float*)lds;
        LAS float* red = sv + 4096;
        for (int k = tid; k < 2048; k += 512) { sv[k] = siluf_(p.c[k]); sv[2048 + k] = siluf_(p.c_ctx[k]); }
        __syncthreads();
        const int kg = tid >> 4, q = tid & 15;
        const float* w = p.w_ada + (size_t)l * 2048 * 6144 + (size_t)(kg * 64) * 6144 + j0 + q * 4;
        f32x4 a0 = {0.f, 0.f, 0.f, 0.f}, a1 = a0;
#pragma unroll 16
        for (int k = 0; k < 64; ++k) { const f32x4 wv = *(const f32x4*)(w + (size_t)k * 6144); a0 += wv * sv[kg * 64 + k]; a1 += wv * sv[2048 + kg * 64 + k]; }
#pragma unroll
        for (int e = 0; e < 4; ++e) { red[(kg * 64 + q * 4 + e) * 2 + 0] = a0[e]; red[(kg * 64 + q * 4 + e) * 2 + 1] = a1[e]; }
        __syncthreads();
        if (tid < 128) { const int v = tid >> 6, j = tid & 63; float sum = 0.f;
#pragma unroll
            for (int g = 0; g < 32; ++g) sum += red[(g * 64 + j) * 2 + v];
            MOD[((size_t)l * 2 + v) * 6144 + j0 + j] = sum + p.b_ada[l * 6144 + j0 + j]; }
        __syncthreads();
    }
    if (bid == nb - 1) {
        for (int i = tid; i < 2048; i += 512) { const int pos = i >> 4, j = i & 15;
            const float f = exp2f(-(float)j * (13.287712379549449f / 16.0f)); const float ang = (float)pos * f;
            ROPE[i] = cosf(ang); ROPE[2048 + i] = sinf(ang); }
    }
    for (int i = bid * 512 + tid; i < DEPTH * 512 * 512; i += nb * 512) { const int rr = (i >> 9) & 511, cc = i & 511; if ((rr >> 7) != (cc >> 7)) WPOOL[i] = 0; }
    LAS float* tile = (LAS float*)lds;
    {
        auto decode = [&](int b, const float*& src, bf16_t*& dst, int& sp, int& dp) {
            if (b < 7040) { const int l = b / 1760, bb = b % 1760, rt = bb / 55, ct = (bb % 55) * 4;
                src = p.w_in + (size_t)l * DM * INC + (size_t)(rt * 64) * INC + ct * 64; sp = INC; dst = WIN + (size_t)l * INC * DM + (size_t)(ct * 64) * DM + rt * 64; dp = DM; }
            else if (b < 8064) { const int tt = b - 7040, lb = tt >> 6, r = tt & 63, rt = r >> 3, ct = (r & 7) * 4;
                src = p.w_branch + (size_t)lb * 512 * DM + (size_t)(rt * 64) * DM + ct * 64; sp = DM; dst = WBR + (size_t)(lb >> 2) * DM * DM + (size_t)(ct * 64) * DM + (lb & 3) * 512 + rt * 64; dp = DM; }
            else if (b < 9088) { const int tt = b - 8064, l = tt >> 8, r = tt & 255, rt = r >> 3, ct = (r & 7) * 4;
                src = p.w_out + (size_t)l * DM * DM + (size_t)(rt * 64) * DM + ct * 64; sp = DM; dst = WOUT + (size_t)l * DM * DM + (size_t)(ct * 64) * DM + rt * 64; dp = DM; }
            else { const int tt = b - 9088, l = tt >> 4, r = tt & 15, rt = r >> 1, ct = (r & 1) * 4;
                src = p.conv_pw + (size_t)l * 512 * 512 + (size_t)(rt * 64) * 512 + ct * 64; sp = 512; dst = WPW + (size_t)l * 512 * 512 + (size_t)(ct * 64) * 512 + rt * 64; dp = 512; }
        };
        const float* src; bf16_t* dst; int sp, dp; f32x4 v[8], vn[8];
        if (bid < 9152) { decode(bid, src, dst, sp, dp); transpose_load<4>(v, src, sp, tid); }
        for (int b = bid; b < 9152; b += nb) {
            const int bn = b + nb; const bool hn = bn < 9152;
            const float* srcn = src; bf16_t* dstn = dst; int spn = sp, dpn = dp;
            if (hn) { decode(bn, srcn, dstn, spn, dpn); transpose_load<4>(vn, srcn, spn, tid); }
            transpose_store<4>(tile, v, dst, dp, tid);
            if (hn) {
#pragma unroll
                for (int i = 0; i < 8; ++i) v[i] = vn[i];
                dst = dstn; dp = dpn; src = srcn; sp = spn; }
        }
    }
    for (int tt = bid; tt < 64; tt += nb) { const int lg = tt >> 2, r = tt & 3, rt = r >> 1, ct = r & 1, l = lg >> 2, gi = lg & 3;
        transpose_batch<1>(tile, p.pool_w + (size_t)lg * 128 * 128 + (size_t)(rt * 64) * 128 + ct * 64, 128,
                           WPOOL + (size_t)l * 512 * 512 + (size_t)(gi * 128 + ct * 64) * 512 + gi * 128 + rt * 64, 512, tid); }
}

__device__ void phase_rows(const Params& p, int l, int bid, int nb) {
    const int tid = opaque_tid(), wid = tid >> 6, lane = tid & 63;
    const float* MOD = (const float*)(p.ws + WS_MOD); const float* Y = (const float*)(p.ws + WS_Y); float* X = (float*)(p.ws + WS_X); bf16_t* H = (bf16_t*)(p.ws + WS_H);
    const int ln = l + 1, nrows = (l == DEPTH - 1) ? SEQ : MT;
    for (int row = bid * 8 + wid; row < nrows; row += nb * 8) {
        const int v = row >= SEQ ? 1 : 0;
        const float* xsrc = (l <= 0) ? (v ? p.ctx + (size_t)(row - SEQ) * DM : p.x + (size_t)row * DM) : X + (size_t)row * DM;
        f32x4 xv[8];
#pragma unroll
        for (int i = 0; i < 8; ++i) xv[i] = *(const f32x4*)(xsrc + (i * 64 + lane) * 4);
        if (l >= 0) {
            f32x4 yv[8]; float ss = 0.f;
#pragma unroll
            for (int i = 0; i < 8; ++i) { yv[i] = *(const f32x4*)(Y + (size_t)row * DM + (i * 64 + lane) * 4); ss += yv[i][0] * yv[i][0] + yv[i][1] * yv[i][1] + yv[i][2] * yv[i][2] + yv[i][3] * yv[i][3]; }
            ss = wave_sum(ss); const float rstd = rsqrtf(ss * (1.0f / DM) + EPS);
            const float* gate = MOD + ((size_t)l * 2 + v) * 6144 + 4096; const float* gp = p.g_post + (size_t)l * DM;
            float* dst = (l == DEPTH - 1) ? p.out + (size_t)row * DM : X + (size_t)row * DM;
#pragma unroll
            for (int i = 0; i < 8; ++i) { const int c = (i * 64 + lane) * 4; const f32x4 g = *(const f32x4*)(gate + c), q = *(const f32x4*)(gp + c);
                xv[i] = xv[i] + g * (yv[i] * rstd * q); *(f32x4*)(dst + c) = xv[i]; }
        }
        if (ln < DEPTH) {
            float ss = 0.f;
#pragma unroll
            for (int i = 0; i < 8; ++i) ss += xv[i][0] * xv[i][0] + xv[i][1] * xv[i][1] + xv[i][2] * xv[i][2] + xv[i][3] * xv[i][3];
            ss = wave_sum(ss); const float rstd = rsqrtf(ss * (1.0f / DM) + EPS);
            const float* md = MOD + ((size_t)ln * 2 + v) * 6144; const float* gpre = p.g_pre + (size_t)ln * DM;
#pragma unroll
            for (int i = 0; i < 8; ++i) { const int c = (i * 64 + lane) * 4; const f32x4 sh = *(const f32x4*)(md + c), sc = *(const f32x4*)(md + 2048 + c), q = *(const f32x4*)(gpre + c);
                const f32x4 hv = xv[i] * rstd * q * (1.0f + sc) + sh;
                u32x2 w; w.x = cvt_pk_bf16(hv[0], hv[1]); w.y = cvt_pk_bf16(hv[2], hv[3]); *(u32x2*)(H + (size_t)row * DM + c) = w; }
        }
    }
}

__device__ void phase_prep(const Params& p, LAS unsigned char* lds, int l, int bid, int nb) {
    const int tid = opaque_tid(), wid = tid >> 6, lane = tid & 63;
    const bf16_t* P = (const bf16_t*)(p.ws + WS_P); bf16_t* QALL = (bf16_t*)(p.ws + WS_QALL); bf16_t* KC = (bf16_t*)(p.ws + WS_KC); bf16_t* VT = (bf16_t*)(p.ws + WS_VT);
    bf16_t* DLN = (bf16_t*)(p.ws + WS_DLN); bf16_t* DP = (bf16_t*)(p.ws + WS_DP); const float* ROPE = (const float*)(p.ws + WS_ROPE);
    const bool lastl = (l == DEPTH - 1);
    LAS float* lu = (LAS float*)lds;
    constexpr int NT32 = MT / 32, NT64 = MT / 64, NUNITS = 3 * NT32 + NT64;
    for (int u = bid; u < NUNITS; u += nb) {
        const int wt = u < 3 * NT32 ? u / NT32 : 3;
        const int tile = u < 3 * NT32 ? u % NT32 : u - 3 * NT32;
        if (wt == 3) {
            const int t0 = tile * 64;
            for (int idx = tid; idx < 160 * 8; idx += 512) {
                const int hd0 = (idx >> 3) * 4, tq = idx & 7, col = hd0 < 512 ? A_V + hd0 : C_V + (hd0 - 512);
                const bf16_t* sp_ = P + (size_t)(t0 + tq * 8) * INC + col; u32x2 w8[8];
#pragma unroll
                for (int j = 0; j < 8; ++j) w8[j] = *(const u32x2*)(sp_ + (size_t)j * INC);
#pragma unroll
                for (int e = 0; e < 4; ++e) { unsigned v[8];
#pragma unroll
                    for (int j = 0; j < 8; ++j) { const unsigned word = (e < 2) ? w8[j].x : w8[j].y; v[j] = (e & 1) ? (word >> 16) : (word & 0xffffu); }
                    u32x4 w; w.x = v[0] | (v[1] << 16); w.y = v[2] | (v[3] << 16); w.z = v[4] | (v[5] << 16); w.w = v[6] | (v[7] << 16);
                    *(u32x4*)(VT + (size_t)(hd0 + e) * MT + t0 + tq * 8) = w; } }
            continue;
        }
        const int t0 = tile * 32; const bool isctx = tile >= SEQ / 32; const bool kvonly = lastl && isctx;
        const int sb = isctx ? SEQ : 0, L = isctx ? NCTX : SEQ;
        if (wt == 2) {
            const float qn = p.q_norm[l * 64 + lane], kn = p.k_norm[l * 64 + lane];
            for (int q4 = 0; q4 < 4; ++q4) {
                const int t = t0 + wid * 4 + q4;
                float cs = 1.f, sn = 0.f;
                if (!isctx) { const int pos = lane < 32 ? (t >> 6) : (t & 63), j = lane & 15; cs = ROPE[pos * 16 + j]; sn = ROPE[2048 + pos * 16 + j]; }
                const bf16_t* prow = P + (size_t)t * INC + lane;
                float xs[18];
#pragma unroll
                for (int hh = 0; hh < 18; ++hh) { const int col = hh < 8 ? A_Q + hh * 64 : (hh < 16 ? C_Q + (hh - 8) * 64 : C_K + (hh - 16) * 64);
                    xs[hh] = (kvonly && hh < 16) ? 0.f : bf2f(prow[col]); }
#pragma unroll
                for (int hh = 0; hh < 18; ++hh) {
                    if (kvonly && hh < 16) continue;
                    if (hh < 8) { QALL[(size_t)t * 1024 + hh * 64 + lane] = f2bf(xs[hh] * QS); }
                    else {
                        const bool isq = hh < 16; const float x = xs[hh];
                        const float ss = wave_sum(x * x); const float rn = rsqrtf(ss * (1.0f / 64.0f) + EPS);
                        float xn = x * rn * (isq ? qn : kn);
                        if (!isctx) { const float pr = __shfl_xor(xn, 16); xn = (lane & 16) ? (xn * cs + pr * sn) : (xn * cs - pr * sn); }
                        if (isq) QALL[(size_t)t * 1024 + hh * 64 + lane] = f2bf(xn * QS); else KC[(size_t)t * 128 + (hh - 16) * 64 + lane] = f2bf(xn);
                    }
                }
            }
            continue;
        }
        if (kvonly) continue;
        if (wt == 1) {
            const int cg4 = tid & 127, tg = tid >> 7, c = cg4 * 4, gi = c >> 7, ksz = 2 << gi;
            const bf16_t* ub = P + (size_t)sb * INC + B_IN + c;
            const int tt0 = t0 - sb + tg * 8;
            int lo = max(tt0 - ksz / 2, 0), hi = min(tt0 + ksz - 1 - ksz / 2, L - 1);
            f32x4 sm = {0.f, 0.f, 0.f, 0.f};
#pragma unroll
            for (int i = 0; i < 16; ++i) { const int idx = lo + i; if (idx <= hi) sm += ld4bf(ub + (size_t)idx * INC); }
#pragma unroll
            for (int tl = 0; tl < 8; ++tl) { const int tt = tt0 + tl;
                const int nlo = max(tt - ksz / 2, 0), nhi = min(tt + ksz - 1 - ksz / 2, L - 1);
                if (nhi > hi) { sm += ld4bf(ub + (size_t)nhi * INC); hi = nhi; }
                if (nlo > lo) { sm -= ld4bf(ub + (size_t)lo * INC); lo = nlo; }
                const f32x4 d = sm * (1.0f / (float)(hi - lo + 1)) - ld4bf(ub + (size_t)tt * INC);
                u32x2 w; w.x = cvt_pk_bf16(d[0], d[1]); w.y = cvt_pk_bf16(d[2], d[3]);
                *(u32x2*)(DP + (size_t)(sb + tt) * 512 + c) = w; }
            continue;
        }
        { const int c = tid;
          { const int c4 = (tid & 127) * 4;
#pragma unroll 8
            for (int rr = tid >> 7; rr < 62; rr += 4) { const int tt = t0 - sb - 15 + rr; f32x4 uv = {0.f, 0.f, 0.f, 0.f};
              if (tt >= 0 && tt < L) { const bf16_t* q = P + (size_t)(sb + tt) * INC + D_GLU + c4; const f32x4 a = ld4bf(q), g = ld4bf(q + 512);
                  uv = (f32x4){a[0] * sigmoidf_(g[0]), a[1] * sigmoidf_(g[1]), a[2] * sigmoidf_(g[2]), a[3] * sigmoidf_(g[3])}; }
              *(LAS f32x4*)(lu + rr * 512 + c4) = uv; } }
          __syncthreads();
          float w[31];
#pragma unroll
          for (int j = 0; j < 31; ++j) w[j] = p.conv_w[((size_t)l * 31 + j) * 512 + c];
          const float cb = p.conv_b[l * 512 + c];
          float y[32];
#pragma unroll
          for (int tl = 0; tl < 32; ++tl) { float a = cb;
#pragma unroll
              for (int j = 0; j < 31; ++j) a += lu[(tl + j) * 512 + c] * w[j];
              y[tl] = a; }
          __syncthreads();
#pragma unroll
          for (int tl = 0; tl < 32; ++tl) lu[tl * 512 + c] = y[tl];
          __syncthreads();
          for (int q = 0; q < 4; ++q) { const int tl = wid * 4 + q; float v[8]; float sm = 0.f;
#pragma unroll
              for (int i = 0; i < 8; ++i) { v[i] = lu[tl * 512 + i * 64 + lane]; sm += v[i]; }
              const float mu = wave_sum(sm) * (1.0f / 512.0f); float qq = 0.f;
#pragma unroll
              for (int i = 0; i < 8; ++i) { const float d = v[i] - mu; qq += d * d; }
              const float rstd = rsqrtf(wave_sum(qq) * (1.0f / 512.0f) + EPS);
#pragma unroll
              for (int i = 0; i < 8; ++i) { const int cc = i * 64 + lane; const float z = (v[i] - mu) * rstd * p.conv_ln_g[l * 512 + cc] + p.conv_ln_b[l * 512 + cc];
                  DLN[(size_t)(t0 + tl) * 512 + cc] = f2bf(siluf_(z)); } }
          __syncthreads(); }
    }
}

struct AttnUnit {
    const bf16_t* kbase; int kpitch;
    int qhead, tok0, ntiles, vth, gcol, ocol;
    int nband, nbp, rlo, kctx0;
    int rq, c0, rs, bh;
};
template <bool MASK>
__device__ __forceinline__ void attn_core(LAS unsigned char* lds, const Params& p, int l, const AttnUnit& a) {
    const int tid = opaque_tid(), lane = tid & 63, r = lane & 31, h2 = lane >> 5;
    const bf16_t* P = (const bf16_t*)(p.ws + WS_P); const bf16_t* QALL = (const bf16_t*)(p.ws + WS_QALL); const bf16_t* VT = (const bf16_t*)(p.ws + WS_VT); bf16_t* O = (bf16_t*)(p.ws + WS_O);
    LAS float* tab = (LAS float*)(lds + 65536);
    if (MASK) { for (int i = tid; i < 465; i += 512) tab[i] = p.na_rpb[((size_t)l * 8 + a.bh) * 465 + i] * LOG2E; }
    bf16x8 qf[4];
    { const bf16_t* qp = QALL + (size_t)(a.tok0 + r) * 1024 + a.qhead * 64 + 8 * h2;
#pragma unroll
      for (int ks = 0; ks < 4; ++ks) qf[ks] = *(const bf16x8*)(qp + 16 * ks); }
    const int lrow = tid >> 3, lch = tid & 7;
    const unsigned st_off = (unsigned)(lrow * 128 + ((lch ^ ((lrow >> 1) & 7)) << 4));
    const bf16_t* vrow = VT + ((size_t)a.vth * 64 + lrow) * MT + lch * 8;
    const bf16_t* krow = a.kbase + (size_t)lrow * a.kpitch + lch * 8;
#define KEY0(j) ((j) < a.nband ? (a.rlo + (j)) * 64 : ((j) < a.nbp ? a.rlo * 64 : a.kctx0 + ((j) - a.nbp) * 64))
    const int pr = (r & 19) | ((r & 4) << 1) | ((r & 8) >> 1);
    const unsigned ksw = (unsigned)((pr >> 1) & 7), vsw = (unsigned)((r >> 1) & 7);
    f32x16 o0, o1;
#pragma unroll
    for (int i = 0; i < 16; ++i) { o0[i] = 0.f; o1[i] = 0.f; }
    float m_run = 0.f, l_run = 0.f; bool started = false;
    const int nbig = a.ntiles >> 1;
    u32x4 kr[2], vr[2];
#define LOADB(J) { _Pragma("unroll") for (int u_ = 0; u_ < 2; ++u_) { const int k0_ = KEY0(2 * (J) + u_); kr[u_] = *(const u32x4*)(krow + (size_t)k0_ * a.kpitch); vr[u_] = *(const u32x4*)(vrow + k0_); } }
#define STOREB(slot) { LAS unsigned char* sb_ = lds + (slot) * 32768; _Pragma("unroll") for (int u_ = 0; u_ < 2; ++u_) { *(LAS u32x4*)(sb_ + u_ * 16384 + st_off) = kr[u_]; *(LAS u32x4*)(sb_ + u_ * 16384 + 8192 + st_off) = vr[u_]; } }
    LOADB(0); STOREB(0);
    __syncthreads();
    for (int J = 0; J < nbig; ++J) {
        const bool more = (J + 1 < nbig);
        if (more) LOADB(J + 1);
#pragma unroll
        for (int u = 0; u < 2; ++u) {
        const int j = 2 * J + u;
        bool active = true; int brow = 0;
        if (MASK) { if (j < a.nband) { const int kr_ = a.rlo + j; active = (kr_ >= a.rs) && (kr_ <= a.rs + 7); brow = kr_ - a.rq + 7; } else if (j < a.nbp) active = false; }
        if (active) {
            LAS unsigned char* Kb = lds + (J & 1) * 32768 + u * 16384; LAS unsigned char* Vb = Kb + 8192;
            bf16x8 kf[8];
#pragma unroll
            for (int ks = 0; ks < 4; ++ks) { const unsigned ch = (unsigned)(2 * ks + h2);
                kf[2 * ks] = *(const LAS bf16x8*)(Kb + pr * 128 + ((ch ^ ksw) << 4));
                kf[2 * ks + 1] = *(const LAS bf16x8*)(Kb + 4096 + pr * 128 + ((ch ^ ksw) << 4)); }
            const float negm = -m_run;
            f32x16 s0, s1;
#pragma unroll
            for (int i = 0; i < 16; ++i) { s0[i] = negm; s1[i] = negm; }
#pragma unroll
            for (int ks = 0; ks < 4; ++ks) {
                s0 = __builtin_amdgcn_mfma_f32_32x32x16_bf16(kf[2 * ks], qf[ks], s0, 0, 0, 0);
                s1 = __builtin_amdgcn_mfma_f32_32x32x16_bf16(kf[2 * ks + 1], qf[ks], s1, 0, 0, 0); }
            bf16x8 vf[8];
#pragma unroll
            for (int kt = 0; kt < 2; ++kt)
#pragma unroll
                for (int sx = 0; sx < 2; ++sx) { const unsigned ch = (unsigned)(4 * kt + 2 * sx + h2);
                    vf[(kt * 2 + sx) * 2] = *(const LAS bf16x8*)(Vb + r * 128 + ((ch ^ vsw) << 4));
                    vf[(kt * 2 + sx) * 2 + 1] = *(const LAS bf16x8*)(Vb + 4096 + r * 128 + ((ch ^ vsw) << 4)); }
            if (MASK) { if (j < a.nband) {
                const int cq = a.c0 + r, cs = clampi(cq - 8, 0, 48);
#pragma unroll
                for (int i = 0; i < 16; ++i) {
                    const int kc0 = 16 * (i >> 3) + 8 * h2 + 4 * ((i >> 2) & 1) + (i & 3), kc1 = kc0 + 32;
                    const bool v0 = (kc0 >= cs) && (kc0 < cs + 16), v1 = (kc1 >= cs) && (kc1 < cs + 16);
                    const float b0 = tab[brow * 31 + clampi(kc0 - cq + 15, 0, 30)], b1 = tab[brow * 31 + clampi(kc1 - cq + 15, 0, 30)];
                    s0[i] = v0 ? s0[i] + b0 : -1e30f; s1[i] = v1 ? s1[i] + b1 : -1e30f; } } }
            float mx = fmaxf(s0[0], s1[0]);
#pragma unroll
            for (int i = 1; i < 16; ++i) mx = fmaxf(fmaxf(mx, s0[i]), s1[i]);
            mx = fmaxf(mx, __shfl_xor(mx, 32));
            const bool slow = !started || (__builtin_amdgcn_ballot_w64(mx > 8.0f) != 0ull);
            if (slow) {
                const float delta = started ? fmaxf(mx, 0.f) : mx;
                const float alpha = fexp2(-delta);
#pragma unroll
                for (int i = 0; i < 16; ++i) { s0[i] -= delta; s1[i] -= delta; o0[i] *= alpha; o1[i] *= alpha; }
                l_run *= alpha; m_run += delta;
            }
            started = true;
            typedef float f32x2_ __attribute__((ext_vector_type(2)));
            f32x2_ acc2 = {0.f, 0.f};
#pragma unroll
            for (int i = 0; i < 16; ++i) { s0[i] = fexp2(s0[i]); s1[i] = fexp2(s1[i]); }
#pragma unroll
            for (int i = 0; i < 8; ++i) { acc2 += (f32x2_){s0[2 * i], s0[2 * i + 1]}; acc2 += (f32x2_){s1[2 * i], s1[2 * i + 1]}; }
            l_run += acc2.x + acc2.y;
            bf16x8 pb[2][2];
#pragma unroll
            for (int sx = 0; sx < 2; ++sx) {
                u32x4 w0, w1;
                w0.x = cvt_pk_bf16(s0[8 * sx + 0], s0[8 * sx + 1]); w0.y = cvt_pk_bf16(s0[8 * sx + 2], s0[8 * sx + 3]); w0.z = cvt_pk_bf16(s0[8 * sx + 4], s0[8 * sx + 5]); w0.w = cvt_pk_bf16(s0[8 * sx + 6], s0[8 * sx + 7]);
                w1.x = cvt_pk_bf16(s1[8 * sx + 0], s1[8 * sx + 1]); w1.y = cvt_pk_bf16(s1[8 * sx + 2], s1[8 * sx + 3]); w1.z = cvt_pk_bf16(s1[8 * sx + 4], s1[8 * sx + 5]); w1.w = cvt_pk_bf16(s1[8 * sx + 6], s1[8 * sx + 7]);
                pb[0][sx] = __builtin_bit_cast(bf16x8, w0); pb[1][sx] = __builtin_bit_cast(bf16x8, w1); }
#pragma unroll
            for (int kt = 0; kt < 2; ++kt)
#pragma unroll
                for (int sx = 0; sx < 2; ++sx) {
                    o0 = __builtin_amdgcn_mfma_f32_32x32x16_bf16(vf[(kt * 2 + sx) * 2], pb[kt][sx], o0, 0, 0, 0);
                    o1 = __builtin_amdgcn_mfma_f32_32x32x16_bf16(vf[(kt * 2 + sx) * 2 + 1], pb[kt][sx], o1, 0, 0, 0); }
        }
        }
        if (more) STOREB((J + 1) & 1);
        __syncthreads();
    }
#undef KEY0
#undef LOADB
#undef STOREB
    { const float lt = l_run + __shfl_xor(l_run, 32); const float inv = 1.0f / lt; const size_t tok = (size_t)(a.tok0 + r);
#pragma unroll
      for (int dt = 0; dt < 2; ++dt)
#pragma unroll
          for (int g4 = 0; g4 < 4; ++g4) { const int dim = dt * 32 + 8 * g4 + 4 * h2;
              const u32x2 gw = *(const u32x2*)(P + tok * INC + a.gcol + dim);
              const float e0 = (dt ? o1[4 * g4 + 0] : o0[4 * g4 + 0]) * inv * siluf_(lo_bf(gw.x)), e1 = (dt ? o1[4 * g4 + 1] : o0[4 * g4 + 1]) * inv * siluf_(hi_bf(gw.x));
              const float e2 = (dt ? o1[4 * g4 + 2] : o0[4 * g4 + 2]) * inv * siluf_(lo_bf(gw.y)), e3 = (dt ? o1[4 * g4 + 3] : o0[4 * g4 + 3]) * inv * siluf_(hi_bf(gw.y));
              u32x2 w; w.x = cvt_pk_bf16(e0, e1); w.y = cvt_pk_bf16(e2, e3);
              *(u32x2*)(O + tok * DM + a.ocol + dim) = w; } }
}

__device__ void phase_mix(const Params& p, LAS unsigned char* lds, int l, int bid, int nb) {
    const int wid = __builtin_amdgcn_readfirstlane(opaque_tid() >> 6);
    const bf16_t* P = (const bf16_t*)(p.ws + WS_P); const bf16_t* KC = (const bf16_t*)(p.ws + WS_KC);
    const int nunits = (l == DEPTH - 1) ? 512 : 528;
    for (int u = bid; u < nunits; u += nb) {
        AttnUnit a;
        if (u < 256 || (u >= 512 && u < 520)) {
            const bool cx = u >= 512; const int uu = cx ? u - 512 : u; const int kvh = uu & 1, tb = uu >> 1, hq = kvh * 4 + (wid & 3);
            a.kbase = KC + kvh * 64; a.kpitch = 128; a.qhead = 8 + hq; a.tok0 = (cx ? SEQ : 0) + tb * 64 + (wid >> 2) * 32; a.ntiles = cx ? 4 : 132; a.vth = 8 + kvh;
            a.gcol = C_G + hq * 64; a.ocol = 1024 + hq * 64; a.nband = 0; a.nbp = 0; a.rlo = 0; a.kctx0 = cx ? SEQ : 0; a.rq = 0; a.c0 = 0; a.rs = 0; a.bh = 0;
            attn_core<false>(lds, p, l, a);
        } else if (u >= 520) {
            const int h = u - 520;
            a.kbase = P + A_K + h * 64; a.kpitch = INC; a.qhead = h; a.tok0 = SEQ + wid * 32; a.ntiles = 4; a.vth = h; a.gcol = A_G + h * 64; a.ocol = h * 64;
            a.nband = 0; a.nbp = 0; a.rlo = 0; a.kctx0 = SEQ; a.rq = 0; a.c0 = 0; a.rs = 0; a.bh = 0;
            attn_core<false>(lds, p, l, a);
        } else {
            const int uu = u - 256, h = uu & 7, rg = uu >> 3, rq0 = rg * 4;
            a.kbase = P + A_K + h * 64; a.kpitch = INC; a.qhead = h; a.rq = rq0 + (wid >> 1); a.c0 = (wid & 1) * 32; a.tok0 = a.rq * 64 + a.c0; a.vth = h; a.gcol = A_G + h * 64; a.ocol = h * 64;
            a.rlo = clampi(rq0 - 4, 0, 120); const int rhi = clampi(rq0 + 3 - 4, 0, 120) + 7; a.nband = rhi - a.rlo + 1; a.nbp = (a.nband + 1) & ~1; a.ntiles = a.nbp + 4; a.kctx0 = SEQ; a.rs = clampi(a.rq - 4, 0, 120); a.bh = h;
            attn_core<true>(lds, p, l, a);
        }
    }
    __syncthreads();
    { pg8::Gemm g{(const bf16_t*)(p.ws + WS_DLN), (const bf16_t*)(p.ws + WS_WPW) + (size_t)l * 512 * 512, 512, 512, 512, (size_t)MT * 512, (size_t)DEPTH * 512 * 512};
      pg8::SmallOrder S{nb, (bid + nb - (nunits % nb)) % nb};
      pg8::EpiSmall E{(bf16_t*)(p.ws + WS_O), P, p.pool_scale + (size_t)l * 512};
      pg8::gemm_phase<pg8::EpiSmall, pg8::SmallOrder>(lds, g, S, E); }
}

__device__ __forceinline__ unsigned xcc_id() { return (unsigned)__builtin_amdgcn_s_getreg((3 << 11) | 20) & 0xFu; }
__device__ __forceinline__ void grid_bar(unsigned* ctl, unsigned& epoch, unsigned x, unsigned nloc, unsigned nx) {
    asm volatile("s_waitcnt vmcnt(0) lgkmcnt(0)" ::: "memory");
    __syncthreads();
    epoch += 1;
    if (threadIdx.x == 0) {
        const unsigned old = __hip_atomic_fetch_add(ctl + 96 + 32 * x, 1u, __ATOMIC_RELAXED, __HIP_MEMORY_SCOPE_AGENT);
        if (old + 1u == epoch * nloc) {
            __builtin_amdgcn_fence(__ATOMIC_RELEASE, "");
            asm volatile("s_waitcnt vmcnt(0)" ::: "memory");
            const unsigned old2 = __hip_atomic_fetch_add(ctl + 64, 1u, __ATOMIC_RELAXED, __HIP_MEMORY_SCOPE_AGENT);
            if (old2 + 1u == epoch * nx) __hip_atomic_store(ctl + 32, epoch, __ATOMIC_RELAXED, __HIP_MEMORY_SCOPE_AGENT);
            else while (__hip_atomic_load(ctl + 32, __ATOMIC_RELAXED, __HIP_MEMORY_SCOPE_AGENT) < epoch) __builtin_amdgcn_s_sleep(1);
            __hip_atomic_store(ctl + 608 + 32 * x, epoch, __ATOMIC_RELAXED, __HIP_MEMORY_SCOPE_AGENT);
        } else while (__hip_atomic_load(ctl + 608 + 32 * x, __ATOMIC_RELAXED, __HIP_MEMORY_SCOPE_AGENT) < epoch) __builtin_amdgcn_s_sleep(1);
        __builtin_amdgcn_fence(__ATOMIC_ACQUIRE, "");
        asm volatile("s_waitcnt vmcnt(0) lgkmcnt(0)" ::: "memory");
    }
    __syncthreads();
}
#define GSYNC() grid_bar(gctr, epoch, xcc, nloc, nxcc)

template <bool MRG>
__device__ __forceinline__ void ctx_tail(LAS unsigned char* lds, const Params& p, int l, int bid, int nb) {
    const int tid = opaque_tid(), wid = tid >> 6, lane = tid & 63, r = lane & 31, h = lane >> 5;
    LAS float* part = (LAS float*)lds;
    const bf16_t* P = (const bf16_t*)(p.ws + WS_P);
    const bf16_t* Asrc = MRG ? (const bf16_t*)(p.ws + WS_O) : (const bf16_t*)(p.ws + WS_Y1);
    const bf16_t* Bsrc = (MRG ? (const bf16_t*)(p.ws + WS_WBR) : (const bf16_t*)(p.ws + WS_WOUT)) + (size_t)l * DM * DM;
    constexpr int NTAG = MRG ? 4 : 1, KQ = MRG ? 128 : 512;
    for (int blk = bid; blk < 256; blk += nb) {
        const int rg = blk & 3, cg = blk >> 2, rh = wid & 1, kq = wid >> 1;
        const int row0 = SEQ + rg * 64 + rh * 32, col0 = cg * 32;
        const bf16_t* A = Asrc + (size_t)(row0 + r) * DM + 8 * h;
        const bf16_t* B = Bsrc + (size_t)(col0 + r) * DM + 8 * h;
        f32x16 tot;
#pragma unroll
        for (int i = 0; i < 16; ++i) tot[i] = 0.f;
#pragma unroll 1
        for (int b = 0; b < NTAG; ++b) {
            f32x16 acc;
#pragma unroll
            for (int i = 0; i < 16; ++i) acc[i] = 0.f;
            const int kbase = MRG ? b * 512 + kq * 128 : kq * 512;
#pragma unroll 8
            for (int ks = 0; ks < KQ / 16; ++ks) {
                const bf16x8 af = *(const bf16x8*)(A + kbase + ks * 16);
                const bf16x8 bf = *(const bf16x8*)(B + kbase + ks * 16);
                acc = __builtin_amdgcn_mfma_f32_32x32x16_bf16(bf, af, acc, 0, 0, 0);
            }
            if (MRG) {
#pragma unroll
                for (int g4 = 0; g4 < 4; ++g4) { const int c = col0 + 8 * g4 + 4 * h;
                    const u32x2 gw = *(const u32x2*)(P + (size_t)(row0 + r) * INC + MERGE + b * DM + c);
                    tot[4 * g4 + 0] += acc[4 * g4 + 0] * sigmoidf_(lo_bf(gw.x)); tot[4 * g4 + 1] += acc[4 * g4 + 1] * sigmoidf_(hi_bf(gw.x));
                    tot[4 * g4 + 2] += acc[4 * g4 + 2] * sigmoidf_(lo_bf(gw.y)); tot[4 * g4 + 3] += acc[4 * g4 + 3] * sigmoidf_(hi_bf(gw.y)); }
            } else tot = acc;
        }
#pragma unroll
        for (int i = 0; i < 16; ++i) part[((kq * 2 + rh) * 16 + i) * 64 + lane] = tot[i];
        __syncthreads();
        float v[4];
#pragma unroll
        for (int e = 0; e < 4; ++e) { float a = 0.f;
#pragma unroll
            for (int q = 0; q < 4; ++q) a += part[((q * 2 + rh) * 16 + 4 * kq + e) * 64 + lane];
            v[e] = a; }
        const size_t row = (size_t)(row0 + r); const int c = col0 + 8 * kq + 4 * h;
        if (MRG) { u32x2 w; w.x = cvt_pk_bf16(v[0], v[1]); w.y = cvt_pk_bf16(v[2], v[3]); *(u32x2*)((bf16_t*)(p.ws + WS_Y1) + row * DM + c) = w; }
        else *(f32x4*)((float*)(p.ws + WS_Y) + row * DM + c) = (f32x4){v[0], v[1], v[2], v[3]};
        __syncthreads();
    }
}

__device__ __forceinline__ void run_phase(const Params& p, LAS unsigned char* lds, int ph, int bid0, int nb0) {
    const int bid = opaque_s(bid0), nb = opaque_s(nb0);
    if (ph == 0) { phase0(p, lds, bid, nb); return; }
    if (ph == 1) { phase_rows(p, -1, bid, nb); return; }
    const int l = opaque_s((ph - 2) / 6), q = (ph - 2) % 6;
    if (q == 0) {
        pg8::Gemm g{(const bf16_t*)(p.ws + WS_H), (const bf16_t*)(p.ws + WS_WIN) + (size_t)l * INC * DM, DM, DM, DM, 0, 0};
        pg8::StaticOrder S; if (l == DEPTH - 1) S.init(SEQ, INC, nb, bid, 5); else S.init(MT, INC, nb, bid);
        pg8::EpiStoreBf16 E{(bf16_t*)(p.ws + WS_P), INC};
        pg8::gemm_phase<pg8::EpiStoreBf16, pg8::StaticOrder>(lds, g, S, E);
    } else if (q == 1) phase_prep(p, lds, l, bid, nb);
    else if (q == 2) phase_mix(p, lds, l, bid, nb);
    else if (q == 3) {
        pg8::Gemm g{(const bf16_t*)(p.ws + WS_O), (const bf16_t*)(p.ws + WS_WBR) + (size_t)l * DM * DM, DM, DM, 512, 512, 512};
        pg8::TagOrder<4> S; S.init(SEQ, DM, nb, bid);
        pg8::EpiMerge E{(bf16_t*)(p.ws + WS_Y1), (const bf16_t*)(p.ws + WS_P)};
        pg8::gemm_phase<pg8::EpiMerge, pg8::TagOrder<4>>(lds, g, S, E);
        if (l != DEPTH - 1) ctx_tail<true>(lds, p, l, bid, nb);
    } else if (q == 4) {
        pg8::Gemm g{(const bf16_t*)(p.ws + WS_Y1), (const bf16_t*)(p.ws + WS_WOUT) + (size_t)l * DM * DM, DM, DM, DM, 0, 0};
        pg8::StaticOrder S; S.init(SEQ, DM, nb, bid);
        pg8::EpiF32 E{(float*)(p.ws + WS_Y), DM};
        pg8::gemm_phase<pg8::EpiF32, pg8::StaticOrder>(lds, g, S, E);
        if (l != DEPTH - 1) ctx_tail<false>(lds, p, l, bid, nb);
    } else phase_rows(p, l, bid, nb);
}
constexpr int NPHASES = 2 + 6 * DEPTH;
#ifndef N_LAUNCH_MODE
#define N_LAUNCH_MODE 1
#endif
__global__ void __launch_bounds__(512) mega_fwd(Params p, int ph_lo, int ph_hi) {
    extern __shared__ __attribute__((aligned(16))) unsigned char shm_raw[];
    LAS unsigned char* lds = (LAS unsigned char*)shm_raw;
    const int bid = blockIdx.x, nb = gridDim.x;
    unsigned* gctr = (unsigned*)(p.ws + WS_CTL); unsigned epoch = 0;
    const unsigned xcc = (unsigned)__builtin_amdgcn_readfirstlane((int)xcc_id());
    unsigned nloc = 1, nxcc = 1;
    if (N_LAUNCH_MODE == 1) {
        if (threadIdx.x == 0) __hip_atomic_fetch_add(gctr + xcc, 1u, __ATOMIC_RELAXED, __HIP_MEMORY_SCOPE_AGENT);
        cg::grid_group grid = cg::this_grid(); grid.sync();
        nloc = __hip_atomic_load(gctr + xcc, __ATOMIC_RELAXED, __HIP_MEMORY_SCOPE_AGENT); nxcc = 0;
#pragma unroll
        for (int j = 0; j < 16; ++j) nxcc += (__hip_atomic_load(gctr + j, __ATOMIC_RELAXED, __HIP_MEMORY_SCOPE_AGENT) != 0u) ? 1u : 0u;
        nloc = (unsigned)__builtin_amdgcn_readfirstlane((int)nloc); nxcc = (unsigned)__builtin_amdgcn_readfirstlane((int)nxcc);
    }
    for (int ph0 = ph_lo; ph0 < ph_hi; ++ph0) {
        const int ph = opaque_s(ph0);
        run_phase(p, lds, ph, bid, nb);
        if (ph0 + 1 < ph_hi) GSYNC();
    }
}

extern "C" void kernel_launch(void* const* d_in, const int* in_sizes, int n_in, void* d_out, int out_size, void* d_ws, size_t ws_size, hipStream_t stream) {
    static int grid = 0;
    if (grid == 0) {
        if (n_in != 21 || ws_size < WS_END) { fprintf(stderr, "kernel_launch: unexpected inputs (%d) or workspace (%zu < %zu)\n", n_in, ws_size, (size_t)WS_END); grid = -1; return; }
        int dev = 0, cus = 0, per_cu = 0;
        (void)hipGetDevice(&dev); (void)hipDeviceGetAttribute(&cus, hipDeviceAttributeMultiprocessorCount, dev);
        if (hipFuncSetAttribute((const void*)mega_fwd, hipFuncAttributeMaxDynamicSharedMemorySize, LDS_BYTES) != hipSuccess) { fprintf(stderr, "kernel_launch: hipFuncSetAttribute failed\n"); grid = -1; return; }
        if (hipOccupancyMaxActiveBlocksPerMultiprocessor(&per_cu, (const void*)mega_fwd, 512, LDS_BYTES) != hipSuccess || per_cu < 1) { fprintf(stderr, "kernel_launch: occupancy query says %d\n", per_cu); per_cu = 1; }
        (void)hipGetLastError();
        grid = cus * 1;
        if (grid <= 0) grid = 256;
    }
    if (grid < 0) return;
    Params p{};
    const float** pp = (const float**)&p;
    for (int i = 0; i < 21; ++i) pp[i] = (const float*)d_in[i];
    p.out = (float*)d_out; p.ws = (unsigned char*)d_ws;
    if (hipMemsetAsync((unsigned char*)d_ws + WS_CTL, 0, 8192, stream) != hipSuccess) { fprintf(stderr, "kernel_launch: memset of the barrier word failed\n"); return; }
    hipError_t e = hipSuccess;
    if (N_LAUNCH_MODE == 1) { int lo = 0, hi = NPHASES; void* args[] = {&p, &lo, &hi};
        e = hipLaunchCooperativeKernel((const void*)mega_fwd, dim3(grid), dim3(512), args, LDS_BYTES, stream); }
    else { for (int ph = 0; ph < NPHASES; ++ph) hipLaunchKernelGGL(mega_fwd, dim3(grid), dim3(512), LDS_BYTES, stream, p, ph, ph + 1); e = hipGetLastError(); }
    if (e != hipSuccess) fprintf(stderr, "kernel_launch: cooperative launch failed: %s (grid %d)\n", hipGetErrorString(e), grid);
}
```

```cpp
#include <hip/hip_runtime.h>
#include <hip/hip_cooperative_groups.h>
#include <cstdio>
#include <cstdint>
namespace cg = cooperative_groups;

#define LAS __attribute__((address_space(3)))
typedef unsigned short bf16_t;
typedef short bf16x8 __attribute__((ext_vector_type(8)));
typedef float f32x4 __attribute__((ext_vector_type(4)));
typedef float f32x16 __attribute__((ext_vector_type(16)));
typedef unsigned u32x4 __attribute__((ext_vector_type(4)));
typedef unsigned u32x2 __attribute__((ext_vector_type(2)));

constexpr int DM = 2048, SEQ = 8192, NCTX = 256, MT = SEQ + NCTX, DEPTH = 4, INC = 14080;
constexpr int A_K = 0, A_V = 512, C_K = 1024, C_V = 1152, A_Q = 1280, C_Q = 1792, A_G = 2304, B_IN = 2816, B_G = 3328, C_G = 3840, D_GLU = 4352, D_G = 5376, MERGE = 5888;
constexpr float EPS = 1e-6f, LOG2E = 1.4426950408889634f, QS = 0.125f * 1.4426950408889634f;

constexpr size_t al256(size_t x) { return (x + 255) & ~(size_t)255; }
constexpr size_t WS_WIN = 0;
constexpr size_t WS_WBR = al256(WS_WIN + (size_t)DEPTH * INC * DM * 2);
constexpr size_t WS_WOUT = al256(WS_WBR + (size_t)DEPTH * DM * DM * 2);
constexpr size_t WS_WPW = al256(WS_WOUT + (size_t)DEPTH * DM * DM * 2);
constexpr size_t WS_WPOOL = WS_WPW + (size_t)DEPTH * 512 * 512 * 2;
constexpr size_t WS_MOD = al256(WS_WPOOL + (size_t)DEPTH * 512 * 512 * 2);
constexpr size_t WS_ROPE = al256(WS_MOD + (size_t)DEPTH * 2 * 6144 * 4);
constexpr size_t WS_H = al256(WS_ROPE + 2 * 128 * 16 * 4);
constexpr size_t WS_P = al256(WS_H + (size_t)MT * DM * 2);
constexpr size_t WS_QALL = al256(WS_P + (size_t)MT * INC * 2);
constexpr size_t WS_KC = al256(WS_QALL + (size_t)MT * 1024 * 2);
constexpr size_t WS_VT = al256(WS_KC + (size_t)MT * 128 * 2);
constexpr size_t WS_DLN = al256(WS_VT + (size_t)10 * 64 * MT * 2);
constexpr size_t WS_DP = WS_DLN + (size_t)MT * 512 * 2;
constexpr size_t WS_O = al256(WS_DP + (size_t)MT * 512 * 2);
constexpr size_t WS_YACC = al256(WS_O + (size_t)MT * DM * 2);
constexpr size_t WS_Y1 = al256(WS_YACC + (size_t)MT * DM * 4);
constexpr size_t WS_Y = al256(WS_Y1 + (size_t)MT * DM * 2);
constexpr size_t WS_X = al256(WS_Y + (size_t)MT * DM * 4);
constexpr size_t WS_CTL = al256(WS_X + (size_t)MT * DM * 4);
constexpr size_t WS_END = WS_CTL + 4096;

constexpr int LDS_BYTES = 131072;
#define N_LAUNCH_MODE 1
#define ZERO_LO WS_H
#define ZERO_HI WS_CTL

struct Params {
    const float *x, *c, *ctx, *c_ctx, *w_ada, *b_ada, *g_pre, *g_post, *w_in, *na_rpb, *pool_w, *pool_scale, *q_norm, *k_norm, *conv_w, *conv_b, *conv_ln_g, *conv_ln_b, *conv_pw, *w_branch, *w_out;
    float* out; unsigned char* ws;
};

__device__ __forceinline__ float bf2f(bf16_t b) { return __uint_as_float(((unsigned)b) << 16); }
__device__ __forceinline__ unsigned cvt_pk_bf16(float lo, float hi) { unsigned r; asm volatile("v_cvt_pk_bf16_f32 %0, %1, %2" : "=v"(r) : "v"(lo), "v"(hi)); return r; }
__device__ __forceinline__ bf16_t f2bf(float f) { return (bf16_t)(cvt_pk_bf16(f, 0.f) & 0xffffu); }
__device__ __forceinline__ float fexp2(float x) { return __builtin_amdgcn_exp2f(x); }
__device__ __forceinline__ float sigmoidf_(float x) { return __builtin_amdgcn_rcpf(1.0f + fexp2(-x * LOG2E)); }
__device__ __forceinline__ float siluf_(float x) { return x * sigmoidf_(x); }
__device__ __forceinline__ float wave_sum(float v) { v += __shfl_xor(v, 32); v += __shfl_xor(v, 16); v += __shfl_xor(v, 8); v += __shfl_xor(v, 4); v += __shfl_xor(v, 2); v += __shfl_xor(v, 1); return v; }
__device__ __forceinline__ float lo_bf(unsigned w) { return __uint_as_float(w << 16); }
__device__ __forceinline__ float hi_bf(unsigned w) { return __uint_as_float(w & 0xffff0000u); }
__device__ __forceinline__ f32x4 ld4bf(const bf16_t* q) { const u32x2 w = *(const u32x2*)q; return (f32x4){lo_bf(w.x), hi_bf(w.x), lo_bf(w.y), hi_bf(w.y)}; }
__device__ __forceinline__ int clampi(int v, int lo, int hi) { return v < lo ? lo : (v > hi ? hi : v); }
__device__ __forceinline__ int opaque_tid() { int t = threadIdx.x; asm volatile("" : "+v"(t)); return t; }
__device__ __forceinline__ int opaque_s(int v) { asm volatile("" : "+s"(v)); return v; }

namespace pg8 {
constexpr int BM = 256, BK = 64, HALF = 128, HTB = HALF * BK * 2, STAGE_BYTES = 8 * HTB, NXCD = 8, WGM = 8;
__host__ __device__ __forceinline__ int lds_byte(int r, int c) { const int st = (r >> 4) * 2 + (c >> 5), rr = r & 15, cc = c & 31, ob = rr * 64 + cc * 2; return st * 1024 + (ob ^ (((ob >> 9) & 1) << 5)); }
__host__ __device__ __forceinline__ void stage_rc(int b, int& R, int& C) { const int st = b / 1024, sb = b % 1024, swz = sb ^ (((sb >> 9) & 1) << 5); R = (st >> 1) * 16 + swz / 64; C = (st & 1) * 32 + (swz % 64) / 2; }
__host__ __device__ __forceinline__ int perm32(int rho) { const int n = rho >> 4, i = rho & 15; return 8 * (i >> 2) + 4 * n + (i & 3); }

struct Unit { int pm, pn, tag; };
struct Gemm { const bf16_t* A; const bf16_t* Bt; int lda, ldb, K; size_t a_tag, b_tag; };

struct StaticOrder {
    int nM, nN, nwg, G, c, extra;
    __device__ void init(int M, int N, int G_, int c_, int extra_ = 0) { nM = M / BM; nN = N / BM; nwg = nM * nN; G = G_; c = c_; extra = extra_; }
    __device__ bool tile(long L, Unit& u) const {
        if (L >= nwg) { if (L >= nwg + extra) return false; u.pm = nM; u.pn = (int)(L - nwg); u.tag = 0; return true; }
        int wgid = (int)L; { const int q = nwg / NXCD, r = nwg % NXCD, xcd = wgid % NXCD, off = wgid / NXCD; wgid = (xcd < r ? xcd * (q + 1) : r * (q + 1) + (xcd - r) * q) + off; }
        const int nig = WGM * nN, gid = wgid / nig, fm = gid * WGM, gsz = (nM - fm) < WGM ? (nM - fm) : WGM;
        u.pm = fm + ((wgid % nig) % gsz); u.pn = (wgid % nig) / gsz; u.tag = 0; return true;
    }
    __device__ bool next(int i, Unit& u) const { return tile((long)i * G + c, u); }
};
template <int NT> struct TagOrder : StaticOrder {
    __device__ bool next(int i, Unit& u) const { if (!tile((long)(i / NT) * G + c, u)) return false; u.tag = i % NT; return true; }
};
struct SmallOrder {
    int G, c;
    __device__ bool next(int i, Unit& u) const { const int L = i * G + c; if (L >= 132) return false; u.tag = L / 66; const int rem = L % 66; u.pm = rem >> 1; u.pn = rem & 1; return true; }
};

struct CtxColsOrder {
    int G, c;
    __device__ bool next(int i, Unit& u) const { const int L = i * G + c; if (L >= 23) return false; u.pm = 32; u.pn = 32 + L; u.tag = 0; return true; }
};

template <class Epi, class Sched>
__device__ __forceinline__ void gemm_phase(LAS unsigned char* lds, const Gemm g, const Sched& S, const Epi& E) {
    const int tid = opaque_tid(), wid = __builtin_amdgcn_readfirstlane(tid >> 6), lane = tid & 63, wr = wid >> 2, wc = wid & 3, fr = lane & 15, fq = lane >> 4;
    const int nt = g.K / BK;
    unsigned voffA[2], voffB[2];
#pragma unroll
    for (int i = 0; i < 2; ++i) { int R, C; stage_rc(tid * 16 + i * 8192, R, C); const int Rb = Epi::PERM ? ((R & ~31) + perm32(R & 31)) : R;
        voffA[i] = (unsigned)(R * g.lda + C) * 2u; voffB[i] = (unsigned)(Rb * g.ldb + C) * 2u; }
    const size_t kstep = (size_t)(BK * 2);
    const size_t hstepA = (size_t)HALF * g.lda * 2, hstepB = (size_t)HALF * g.ldb * 2;
    const unsigned ldsw = (unsigned)wid * 1024u;
    const int aoff = lds_byte(wr * 64 + fr, fq * 8), boff = lds_byte(wc * 32 + fr, fq * 8);
#define PG8_UA(u) ((const char*)g.A + ((size_t)(u).pm * BM * g.lda + (size_t)(u).tag * g.a_tag) * 2)
#define PG8_UB(u) ((const char*)g.Bt + ((size_t)(u).pn * BM * g.ldb + (size_t)(u).tag * g.b_tag) * 2)
#define PG8_SA(b, h) (((b) * 2 + (h)) * HTB)
#define PG8_SB(b, h) ((4 + (b) * 2 + (h)) * HTB)
#define PG8_STAGE(bufoff, gbase, voff) do { _Pragma("unroll") for (int _i = 0; _i < 2; ++_i) \
        __builtin_amdgcn_global_load_lds((const unsigned*)((const char*)(gbase) + (voff)[_i]), (LAS unsigned*)(lds + (bufoff) + ldsw + _i * 8192), 16, 0, 0); } while (0)
#define PG8_LDA(dst, b, h) do { _Pragma("unroll") for (int m = 0; m < 4; ++m) _Pragma("unroll") for (int k = 0; k < 2; ++k) dst[m][k] = *(const LAS bf16x8*)(lds + PG8_SA(b, h) + aoff + m * 2048 + k * 1024); } while (0)
#define PG8_LDB(dst, b, h) do { _Pragma("unroll") for (int n = 0; n < 2; ++n) _Pragma("unroll") for (int k = 0; k < 2; ++k) dst[n][k] = *(const LAS bf16x8*)(lds + PG8_SB(b, h) + boff + n * 2048 + k * 1024); } while (0)
#define PG8_MMA(ai, bj, At, Bt) do { __builtin_amdgcn_s_setprio(1); _Pragma("unroll") for (int m = 0; m < 4; ++m) _Pragma("unroll") for (int n = 0; n < 2; ++n) _Pragma("unroll") for (int k = 0; k < 2; ++k) \
        acc[ai][bj][m][n] = __builtin_amdgcn_mfma_f32_16x16x32_bf16(Bt[n][k], At[m][k], acc[ai][bj][m][n], 0, 0, 0); __builtin_amdgcn_s_setprio(0); } while (0)
#define PG8_WAIT_V(n) asm volatile("s_waitcnt vmcnt(" #n ")" ::: "memory")
#define PG8_WAIT_L(n) asm volatile("s_waitcnt lgkmcnt(" #n ")" ::: "memory")
#define PG8_BAR __builtin_amdgcn_s_barrier()
#define PG8_SCHED __builtin_amdgcn_sched_barrier(0)
    Unit cur, nxt; int ui = 0;
    if (!S.next(0, cur)) return;
    f32x4 acc[2][2][4][2];
#pragma unroll
    for (int a = 0; a < 2; ++a)
#pragma unroll
        for (int b = 0; b < 2; ++b)
#pragma unroll
            for (int m = 0; m < 4; ++m)
#pragma unroll
                for (int n = 0; n < 2; ++n) acc[a][b][m][n] = (f32x4){0.f, 0.f, 0.f, 0.f};
    bf16x8 At[4][2], B0[2][2], B1[2][2];
    const char* cA = PG8_UA(cur); const char* cB = PG8_UB(cur);
    PG8_STAGE(PG8_SB(0, 0), cB, voffB); PG8_STAGE(PG8_SB(0, 1), cB + hstepB, voffB); PG8_STAGE(PG8_SA(0, 0), cA, voffA); PG8_STAGE(PG8_SA(0, 1), cA + hstepA, voffA);
    if (wr == 1) PG8_BAR;
    PG8_WAIT_V(2); PG8_BAR;
    PG8_STAGE(PG8_SB(1, 0), cB + kstep, voffB); PG8_STAGE(PG8_SA(1, 0), cA + kstep, voffA); PG8_STAGE(PG8_SB(1, 1), cB + hstepB + kstep, voffB);
    PG8_WAIT_V(6); PG8_BAR;
    for (;;) {
        const bool has_next = S.next(ui + 1, nxt);
        const char* nA = has_next ? PG8_UA(nxt) : cA; const char* nB = has_next ? PG8_UB(nxt) : cB;
        for (int t = 0; t < nt; t += 2) {
            const bool last = (t == nt - 2);
            const char* a1 = cA + (size_t)(t + 1) * kstep;
            const char* a2 = last ? nA : cA + (size_t)(t + 2) * kstep; const char* b2 = last ? nB : cB + (size_t)(t + 2) * kstep;
            const char* a3 = a2 + kstep; const char* b3 = b2 + kstep;
            PG8_LDB(B0, 0, 0); PG8_LDB(B1, 0, 1); PG8_SCHED; PG8_LDA(At, 0, 0); PG8_STAGE(PG8_SA(1, 1), a1 + hstepA, voffA);
            PG8_WAIT_V(8); PG8_WAIT_L(0); PG8_BAR; PG8_MMA(0, 0, At, B0); PG8_MMA(0, 1, At, B1); PG8_BAR; PG8_SCHED;
            PG8_LDA(At, 0, 1); PG8_STAGE(PG8_SB(0, 0), b2, voffB); PG8_STAGE(PG8_SB(0, 1), b2 + hstepB, voffB); PG8_STAGE(PG8_SA(0, 0), a2, voffA);
            PG8_WAIT_V(8); PG8_WAIT_L(0); PG8_BAR; PG8_MMA(1, 0, At, B0); PG8_MMA(1, 1, At, B1); PG8_BAR; PG8_SCHED;
            PG8_LDB(B0, 1, 0); PG8_LDB(B1, 1, 1); PG8_SCHED; PG8_LDA(At, 1, 0); PG8_STAGE(PG8_SA(0, 1), a2 + hstepA, voffA);
            PG8_WAIT_V(8); PG8_WAIT_L(0); PG8_BAR; PG8_MMA(0, 0, At, B0); PG8_MMA(0, 1, At, B1); PG8_BAR; PG8_SCHED;
            PG8_LDA(At, 1, 1); PG8_STAGE(PG8_SB(1, 0), b3, voffB); PG8_STAGE(PG8_SB(1, 1), b3 + hstepB, voffB); PG8_STAGE(PG8_SA(1, 0), a3, voffA);
            PG8_WAIT_V(8); PG8_WAIT_L(0); PG8_BAR; PG8_MMA(1, 0, At, B0); PG8_MMA(1, 1, At, B1); PG8_BAR; PG8_SCHED;
        }
        if (wr == 0) PG8_BAR;
        E(acc, cur, wr, wc, fr, fq);
        if (!has_next) break;
        if (!(Epi::CHAIN && cur.tag != Epi::LAST_TAG)) {
#pragma unroll
        for (int a = 0; a < 2; ++a)
#pragma unroll
            for (int b = 0; b < 2; ++b)
#pragma unroll
                for (int m = 0; m < 4; ++m)
#pragma unroll
                    for (int n = 0; n < 2; ++n) acc[a][b][m][n] = (f32x4){0.f, 0.f, 0.f, 0.f};
        }
        cur = nxt; cA = nA; cB = nB; ++ui;
        if (wr == 1) PG8_BAR;
    }
    PG8_WAIT_V(0);
    PG8_BAR;
#undef PG8_UA
#undef PG8_UB
#undef PG8_SA
#undef PG8_SB
#undef PG8_STAGE
#undef PG8_LDA
#undef PG8_LDB
#undef PG8_MMA
#undef PG8_WAIT_V
#undef PG8_WAIT_L
#undef PG8_BAR
#undef PG8_SCHED
}

struct EpiStoreBf16 {
    static constexpr bool PERM = true, CHAIN = false; static constexpr int LAST_TAG = 0;
    bf16_t* O; int ldc;
    __device__ __forceinline__ void operator()(const f32x4 (&acc)[2][2][4][2], const Unit& u, int wr, int wc, int fr, int fq) const {
        const int row0 = u.pm * BM + wr * 64 + fr, col0 = u.pn * BM + wc * 32 + 8 * fq;
#pragma unroll
        for (int ai = 0; ai < 2; ++ai)
#pragma unroll
            for (int m = 0; m < 4; ++m) { bf16_t* rowp = O + (size_t)(row0 + ai * HALF + m * 16) * ldc + col0;
#pragma unroll
                for (int bj = 0; bj < 2; ++bj) { const f32x4 v0 = acc[ai][bj][m][0], v1 = acc[ai][bj][m][1];
                    u32x4 w; w.x = cvt_pk_bf16(v0[0], v0[1]); w.y = cvt_pk_bf16(v0[2], v0[3]); w.z = cvt_pk_bf16(v1[0], v1[1]); w.w = cvt_pk_bf16(v1[2], v1[3]);
                    *(u32x4*)(rowp + bj * HALF) = w; } }
    }
};
struct EpiF32 {
    static constexpr bool PERM = false, CHAIN = false; static constexpr int LAST_TAG = 0;
    float* C; int ldc;
    __device__ __forceinline__ void operator()(const f32x4 (&acc)[2][2][4][2], const Unit& u, int wr, int wc, int fr, int fq) const {
        const int row0 = u.pm * BM + wr * 64 + fr, col0 = u.pn * BM + wc * 32 + 4 * fq;
#pragma unroll
        for (int ai = 0; ai < 2; ++ai)
#pragma unroll
            for (int m = 0; m < 4; ++m) { float* rowp = C + (size_t)(row0 + ai * HALF + m * 16) * ldc + col0;
#pragma unroll
                for (int bj = 0; bj < 2; ++bj)
#pragma unroll
                    for (int n = 0; n < 2; ++n) *(f32x4*)(rowp + bj * HALF + n * 16) = acc[ai][bj][m][n]; }
    }
};
struct EpiSmall {
    static constexpr bool PERM = true, CHAIN = false; static constexpr int LAST_TAG = 0;
    bf16_t* O; const bf16_t* P; const float* pool_scale;
    __device__ __forceinline__ void operator()(const f32x4 (&acc)[2][2][4][2], const Unit& u, int wr, int wc, int fr, int fq) const {
        const int row0 = u.pm * BM + wr * 64 + fr, col0 = u.pn * BM + wc * 32 + 8 * fq;
        const int gcol = u.tag ? B_G : D_G, ocol = u.tag ? 512 : 1536;
#pragma unroll
        for (int bj = 0; bj < 2; ++bj) {
            const int c = col0 + bj * HALF;
            f32x4 s0 = (f32x4){1.f, 1.f, 1.f, 1.f}, s1 = s0;
            if (u.tag) { s0 = *(const f32x4*)(pool_scale + c); s1 = *(const f32x4*)(pool_scale + c + 4); }
#pragma unroll
            for (int ai = 0; ai < 2; ++ai)
#pragma unroll
                for (int m = 0; m < 4; ++m) {
                    const size_t row = (size_t)(row0 + ai * HALF + m * 16);
                    const u32x4 gw = *(const u32x4*)(P + row * INC + gcol + c);
                    const f32x4 v0 = acc[ai][bj][m][0] * s0, v1 = acc[ai][bj][m][1] * s1;
                    u32x4 w;
                    w.x = cvt_pk_bf16(v0[0] * siluf_(lo_bf(gw.x)), v0[1] * siluf_(hi_bf(gw.x)));
                    w.y = cvt_pk_bf16(v0[2] * siluf_(lo_bf(gw.y)), v0[3] * siluf_(hi_bf(gw.y)));
                    w.z = cvt_pk_bf16(v1[0] * siluf_(lo_bf(gw.z)), v1[1] * siluf_(hi_bf(gw.z)));
                    w.w = cvt_pk_bf16(v1[2] * siluf_(lo_bf(gw.w)), v1[3] * siluf_(hi_bf(gw.w)));
                    *(u32x4*)(O + row * DM + ocol + c) = w;
                }
        }
    }
};
struct EpiMerge {
    static constexpr bool PERM = true, CHAIN = true; static constexpr int LAST_TAG = 3;
    bf16_t* Y1; const bf16_t* P;
    __device__ __forceinline__ void operator()(f32x4 (&acc)[2][2][4][2], const Unit& u, int wr, int wc, int fr, int fq) const {
        const int row0 = u.pm * BM + wr * 64 + fr, col0 = u.pn * BM + wc * 32 + 8 * fq;
        const int b = u.tag;
#pragma unroll
        for (int ai = 0; ai < 2; ++ai)
#pragma unroll
            for (int m = 0; m < 4; ++m) {
                const size_t row = (size_t)(row0 + ai * HALF + m * 16);
#pragma unroll
                for (int bj = 0; bj < 2; ++bj) {
                    const int c = col0 + bj * HALF;
                    const u32x4 gw = *(const u32x4*)(P + row * INC + MERGE + b * DM + c);
                    float eb[8] = {fexp2(-lo_bf(gw.x) * LOG2E), fexp2(-hi_bf(gw.x) * LOG2E), fexp2(-lo_bf(gw.y) * LOG2E), fexp2(-hi_bf(gw.y) * LOG2E),
                                   fexp2(-lo_bf(gw.z) * LOG2E), fexp2(-hi_bf(gw.z) * LOG2E), fexp2(-lo_bf(gw.w) * LOG2E), fexp2(-hi_bf(gw.w) * LOG2E)};
                    f32x4 v0 = acc[ai][bj][m][0], v1 = acc[ai][bj][m][1];
                    if (b != 3) {
                        const u32x4 gn = *(const u32x4*)(P + row * INC + MERGE + (b + 1) * DM + c);
                        float en[8] = {fexp2(-lo_bf(gn.x) * LOG2E), fexp2(-hi_bf(gn.x) * LOG2E), fexp2(-lo_bf(gn.y) * LOG2E), fexp2(-hi_bf(gn.y) * LOG2E),
                                       fexp2(-lo_bf(gn.z) * LOG2E), fexp2(-hi_bf(gn.z) * LOG2E), fexp2(-lo_bf(gn.w) * LOG2E), fexp2(-hi_bf(gn.w) * LOG2E)};
#pragma unroll
                        for (int e = 0; e < 4; ++e) { v0[e] *= (1.0f + en[e]) * __builtin_amdgcn_rcpf(1.0f + eb[e]); v1[e] *= (1.0f + en[4 + e]) * __builtin_amdgcn_rcpf(1.0f + eb[4 + e]); }
                        acc[ai][bj][m][0] = v0; acc[ai][bj][m][1] = v1;
                    } else {
#pragma unroll
                        for (int e = 0; e < 4; ++e) { v0[e] *= __builtin_amdgcn_rcpf(1.0f + eb[e]); v1[e] *= __builtin_amdgcn_rcpf(1.0f + eb[4 + e]); }
                        u32x4 w; w.x = cvt_pk_bf16(v0[0], v0[1]); w.y = cvt_pk_bf16(v0[2], v0[3]); w.z = cvt_pk_bf16(v1[0], v1[1]); w.w = cvt_pk_bf16(v1[2], v1[3]);
                        *(u32x4*)(Y1 + row * DM + c) = w;
                    }
                }
            }
    }
};
}

template <int NB>
__device__ __forceinline__ void transpose_load(f32x4 (&v)[2 * NB], const float* src, int sp, int tid) {
#pragma unroll
    for (int i = 0; i < 2 * NB; ++i) { const int idx = tid + i * 512, r = idx / (16 * NB), cc = idx % (16 * NB);
        v[i] = *(const f32x4*)(src + (size_t)r * sp + cc * 4); }
}
template <int NB>
__device__ __forceinline__ void transpose_store(LAS float* tile, const f32x4 (&v)[2 * NB], bf16_t* dst, int dp, int tid) {
#pragma unroll
    for (int i = 0; i < 2 * NB; ++i) { const int idx = tid + i * 512, r = idx / (16 * NB), cc = idx % (16 * NB), j = cc >> 4, c4 = cc & 15;
        LAS float* t = tile + j * (64 * 65) + r * 65 + c4 * 4; t[0] = v[i][0]; t[1] = v[i][1]; t[2] = v[i][2]; t[3] = v[i][3]; }
    __syncthreads();
    { const int c = tid >> 3, r8 = (tid & 7) * 8;
#pragma unroll
      for (int j = 0; j < NB; ++j) { float w8[8];
#pragma unroll
          for (int e = 0; e < 8; ++e) w8[e] = tile[j * (64 * 65) + (r8 + e) * 65 + c];
          u32x4 w; w.x = cvt_pk_bf16(w8[0], w8[1]); w.y = cvt_pk_bf16(w8[2], w8[3]); w.z = cvt_pk_bf16(w8[4], w8[5]); w.w = cvt_pk_bf16(w8[6], w8[7]);
          *(u32x4*)(dst + (size_t)(j * 64 + c) * dp + r8) = w; } }
    __syncthreads();
}
template <int NB>
__device__ __forceinline__ void transpose_batch(LAS float* tile, const float* src, int sp, bf16_t* dst, int dp, int tid) {
    f32x4 v[2 * NB]; transpose_load<NB>(v, src, sp, tid); transpose_store<NB>(tile, v, dst, dp, tid);
}

__device__ void phase0(const Params& p, LAS unsigned char* lds, int bid, int nb) {
    const int tid = opaque_tid();
    bf16_t* WIN = (bf16_t*)(p.ws + WS_WIN); bf16_t* WBR = (bf16_t*)(p.ws + WS_WBR); bf16_t* WOUT = (bf16_t*)(p.ws + WS_WOUT);
    bf16_t* WPW = (bf16_t*)(p.ws + WS_WPW); bf16_t* WPOOL = (bf16_t*)(p.ws + WS_WPOOL);
    float* MOD = (float*)(p.ws + WS_MOD); float* ROPE = (float*)(p.ws + WS_ROPE);
    for (int task = bid; task < 384; task += nb) {
        const int l = task / 96, j0 = (task % 96) * 64;
        LAS float* sv = (LAS float*)lds;
        LAS float* red = sv + 4096;
        for (int k = tid; k < 2048; k += 512) { sv[k] = siluf_(p.c[k]); sv[2048 + k] = siluf_(p.c_ctx[k]); }
        __syncthreads();
        const int kg = tid >> 4, q = tid & 15;
        const float* w = p.w_ada + (size_t)l * 2048 * 6144 + (size_t)(kg * 64) * 6144 + j0 + q * 4;
        f32x4 a0 = {0.f, 0.f, 0.f, 0.f}, a1 = a0;
#pragma unroll 16
        for (int k = 0; k < 64; ++k) { const f32x4 wv = *(const f32x4*)(w + (size_t)k * 6144); a0 += wv * sv[kg * 64 + k]; a1 += wv * sv[2048 + kg * 64 + k]; }
#pragma unroll
        for (int e = 0; e < 4; ++e) { red[(kg * 64 + q * 4 + e) * 2 + 0] = a0[e]; red[(kg * 64 + q * 4 + e) * 2 + 1] = a1[e]; }
        __syncthreads();
        if (tid < 128) { const int v = tid >> 6, j = tid & 63; float sum = 0.f;
#pragma unroll
            for (int g = 0; g < 32; ++g) sum += red[(g * 64 + j) * 2 + v];
            MOD[((size_t)l * 2 + v) * 6144 + j0 + j] = sum + p.b_ada[l * 6144 + j0 + j]; }
        __syncthreads();
    }
    if (bid == nb - 1) {
        for (int i = tid; i < 2048; i += 512) { const int pos = i >> 4, j = i & 15;
            const float f = exp2f(-(float)j * (13.287712379549449f / 16.0f)); const float ang = (float)pos * f;
            ROPE[i] = cosf(ang); ROPE[2048 + i] = sinf(ang); }
    }
    for (int i = bid * 512 + tid; i < DEPTH * 512 * 512; i += nb * 512) { const int rr = (i >> 9) & 511, cc = i & 511; if ((rr >> 7) != (cc >> 7)) WPOOL[i] = 0; }
    LAS float* tile = (LAS float*)lds;
    {
        auto decode = [&](int b, const float*& src, bf16_t*& dst, int& sp, int& dp) {
            if (b < 7040) { const int l = b / 1760, bb = b % 1760, rt = bb / 55, ct = (bb % 55) * 4;
                src = p.w_in + (size_t)l * DM * INC + (size_t)(rt * 64) * INC + ct * 64; sp = INC; dst = WIN + (size_t)l * INC * DM + (size_t)(ct * 64) * DM + rt * 64; dp = DM; }
            else if (b < 8064) { const int tt = b - 7040, lb = tt >> 6, r = tt & 63, rt = r >> 3, ct = (r & 7) * 4;
                src = p.w_branch + (size_t)lb * 512 * DM + (size_t)(rt * 64) * DM + ct * 64; sp = DM; dst = WBR + (size_t)(lb >> 2) * DM * DM + (size_t)(ct * 64) * DM + (lb & 3) * 512 + rt * 64; dp = DM; }
            else if (b < 9088) { const int tt = b - 8064, l = tt >> 8, r = tt & 255, rt = r >> 3, ct = (r & 7) * 4;
                src = p.w_out + (size_t)l * DM * DM + (size_t)(rt * 64) * DM + ct * 64; sp = DM; dst = WOUT + (size_t)l * DM * DM + (size_t)(ct * 64) * DM + rt * 64; dp = DM; }
            else { const int tt = b - 9088, l = tt >> 4, r = tt & 15, rt = r >> 1, ct = (r & 1) * 4;
                src = p.conv_pw + (size_t)l * 512 * 512 + (size_t)(rt * 64) * 512 + ct * 64; sp = 512; dst = WPW + (size_t)l * 512 * 512 + (size_t)(ct * 64) * 512 + rt * 64; dp = 512; }
        };
        const float* src; bf16_t* dst; int sp, dp; f32x4 v[8], vn[8];
        if (bid < 9152) { decode(bid, src, dst, sp, dp); transpose_load<4>(v, src, sp, tid); }
        for (int b = bid; b < 9152; b += nb) {
            const int bn = b + nb; const bool hn = bn < 9152;
            const float* srcn = src; bf16_t* dstn = dst; int spn = sp, dpn = dp;
            if (hn) { decode(bn, srcn, dstn, spn, dpn); transpose_load<4>(vn, srcn, spn, tid); }
            transpose_store<4>(tile, v, dst, dp, tid);
            if (hn) {
#pragma unroll
                for (int i = 0; i < 8; ++i) v[i] = vn[i];
                dst = dstn; dp = dpn; src = srcn; sp = spn; }
        }
    }
    for (int tt = bid; tt < 64; tt += nb) { const int lg = tt >> 2, r = tt & 3, rt = r >> 1, ct = r & 1, l = lg >> 2, gi = lg & 3;
        transpose_batch<1>(tile, p.pool_w + (size_t)lg * 128 * 128 + (size_t)(rt * 64) * 128 + ct * 64, 128,
                           WPOOL + (size_t)l * 512 * 512 + (size_t)(gi * 128 + ct * 64) * 512 + gi * 128 + rt * 64, 512, tid); }
}

__device__ void phase_rows(const Params& p, int l, int bid, int nb) {
    const int tid = opaque_tid(), wid = tid >> 6, lane = tid & 63;
    const float* MOD = (const float*)(p.ws + WS_MOD); const float* Y = (const float*)(p.ws + WS_Y); float* X = (float*)(p.ws + WS_X); bf16_t* H = (bf16_t*)(p.ws + WS_H);
    const int ln = l + 1, nrows = (l == DEPTH - 1) ? SEQ : MT;
    for (int row = bid * 8 + wid; row < nrows; row += nb * 8) {
        const int v = row >= SEQ ? 1 : 0;
        const float* xsrc = (l <= 0) ? (v ? p.ctx + (size_t)(row - SEQ) * DM : p.x + (size_t)row * DM) : X + (size_t)row * DM;
        f32x4 xv[8];
#pragma unroll
        for (int i = 0; i < 8; ++i) xv[i] = *(const f32x4*)(xsrc + (i * 64 + lane) * 4);
        if (l >= 0) {
            f32x4 yv[8]; float ss = 0.f;
#pragma unroll
            for (int i = 0; i < 8; ++i) { yv[i] = *(const f32x4*)(Y + (size_t)row * DM + (i * 64 + lane) * 4); ss += yv[i][0] * yv[i][0] + yv[i][1] * yv[i][1] + yv[i][2] * yv[i][2] + yv[i][3] * yv[i][3]; }
            ss = wave_sum(ss); const float rstd = rsqrtf(ss * (1.0f / DM) + EPS);
            const float* gate = MOD + ((size_t)l * 2 + v) * 6144 + 4096; const float* gp = p.g_post + (size_t)l * DM;
            float* dst = (l == DEPTH - 1) ? p.out + (size_t)row * DM : X + (size_t)row * DM;
#pragma unroll
            for (int i = 0; i < 8; ++i) { const int c = (i * 64 + lane) * 4; const f32x4 g = *(const f32x4*)(gate + c), q = *(const f32x4*)(gp + c);
                xv[i] = xv[i] + g * (yv[i] * rstd * q); *(f32x4*)(dst + c) = xv[i]; }
        }
        if (ln < DEPTH) {
            float ss = 0.f;
#pragma unroll
            for (int i = 0; i < 8; ++i) ss += xv[i][0] * xv[i][0] + xv[i][1] * xv[i][1] + xv[i][2] * xv[i][2] + xv[i][3] * xv[i][3];
            ss = wave_sum(ss); const float rstd = rsqrtf(ss * (1.0f / DM) + EPS);
            const float* md = MOD + ((size_t)ln * 2 + v) * 6144; const float* gpre = p.g_pre + (size_t)ln * DM;
#pragma unroll
            for (int i = 0; i < 8; ++i) { const int c = (i * 64 + lane) * 4; const f32x4 sh = *(const f32x4*)(md + c), sc = *(const f32x4*)(md + 2048 + c), q = *(const f32x4*)(gpre + c);
                const f32x4 hv = xv[i] * rstd * q * (1.0f + sc) + sh;
                u32x2 w; w.x = cvt_pk_bf16(hv[0], hv[1]); w.y = cvt_pk_bf16(hv[2], hv[3]); *(u32x2*)(H + (size_t)row * DM + c) = w; }
        }
    }
}

__device__ void phase_prep(const Params& p, LAS unsigned char* lds, int l, int bid, int nb) {
    const int tid = opaque_tid(), wid = tid >> 6, lane = tid & 63;
    const bf16_t* P = (const bf16_t*)(p.ws + WS_P); bf16_t* QALL = (bf16_t*)(p.ws + WS_QALL); bf16_t* KC = (bf16_t*)(p.ws + WS_KC); bf16_t* VT = (bf16_t*)(p.ws + WS_VT);
    bf16_t* DLN = (bf16_t*)(p.ws + WS_DLN); bf16_t* DP = (bf16_t*)(p.ws + WS_DP); const float* ROPE = (const float*)(p.ws + WS_ROPE);
    const bool lastl = (l == DEPTH - 1);
    LAS float* lu = (LAS float*)lds;
    constexpr int NT32 = MT / 32, NT64 = MT / 64, NUNITS = 3 * NT32 + NT64;
    for (int u = bid; u < NUNITS; u += nb) {
        const int wt = u < 3 * NT32 ? u / NT32 : 3;
        const int tile = u < 3 * NT32 ? u % NT32 : u - 3 * NT32;
        if (wt == 3) {
            const int t0 = tile * 64;
            for (int idx = tid; idx < 160 * 8; idx += 512) {
                const int hd0 = (idx >> 3) * 4, tq = idx & 7, col = hd0 < 512 ? A_V + hd0 : C_V + (hd0 - 512);
                const bf16_t* sp_ = P + (size_t)(t0 + tq * 8) * INC + col; u32x2 w8[8];
#pragma unroll
                for (int j = 0; j < 8; ++j) w8[j] = *(const u32x2*)(sp_ + (size_t)j * INC);
#pragma unroll
                for (int e = 0; e < 4; ++e) { unsigned v[8];
#pragma unroll
                    for (int j = 0; j < 8; ++j) { const unsigned word = (e < 2) ? w8[j].x : w8[j].y; v[j] = (e & 1) ? (word >> 16) : (word & 0xffffu); }
                    u32x4 w; w.x = v[0] | (v[1] << 16); w.y = v[2] | (v[3] << 16); w.z = v[4] | (v[5] << 16); w.w = v[6] | (v[7] << 16);
                    *(u32x4*)(VT + (size_t)(hd0 + e) * MT + t0 + tq * 8) = w; } }
            continue;
        }
        const int t0 = tile * 32; const bool isctx = tile >= SEQ / 32; const bool kvonly = lastl && isctx;
        const int sb = isctx ? SEQ : 0, L = isctx ? NCTX : SEQ;
        if (wt == 2) {
            const float qn = p.q_norm[l * 64 + lane], kn = p.k_norm[l * 64 + lane];
            for (int q4 = 0; q4 < 4; ++q4) {
                const int t = t0 + wid * 4 + q4;
                float cs = 1.f, sn = 0.f;
                if (!isctx) { const int pos = lane < 32 ? (t >> 6) : (t & 63), j = lane & 15; cs = ROPE[pos * 16 + j]; sn = ROPE[2048 + pos * 16 + j]; }
                const bf16_t* prow = P + (size_t)t * INC + lane;
                float xs[18];
#pragma unroll
                for (int hh = 0; hh < 18; ++hh) { const int col = hh < 8 ? A_Q + hh * 64 : (hh < 16 ? C_Q + (hh - 8) * 64 : C_K + (hh - 16) * 64);
                    xs[hh] = (kvonly && hh < 16) ? 0.f : bf2f(prow[col]); }
#pragma unroll
                for (int hh = 0; hh < 18; ++hh) {
                    if (kvonly && hh < 16) continue;
                    if (hh < 8) { QALL[(size_t)t * 1024 + hh * 64 + lane] = f2bf(xs[hh] * QS); }
                    else {
                        const bool isq = hh < 16; const float x = xs[hh];
                        const float ss = wave_sum(x * x); const float rn = rsqrtf(ss * (1.0f / 64.0f) + EPS);
                        float xn = x * rn * (isq ? qn : kn);
                        if (!isctx) { const float pr = __shfl_xor(xn, 16); xn = (lane & 16) ? (xn * cs + pr * sn) : (xn * cs - pr * sn); }
                        if (isq) QALL[(size_t)t * 1024 + hh * 64 + lane] = f2bf(xn * QS); else KC[(size_t)t * 128 + (hh - 16) * 64 + lane] = f2bf(xn);
                    }
                }
            }
            continue;
        }
        if (kvonly) continue;
        if (wt == 1) {
            const int cg4 = tid & 127, tg = tid >> 7, c = cg4 * 4, gi = c >> 7, ksz = 2 << gi;
            const bf16_t* ub = P + (size_t)sb * INC + B_IN + c;
            const int tt0 = t0 - sb + tg * 8;
            int lo = max(tt0 - ksz / 2, 0), hi = min(tt0 + ksz - 1 - ksz / 2, L - 1);
            f32x4 sm = {0.f, 0.f, 0.f, 0.f};
#pragma unroll
            for (int i = 0; i < 16; ++i) { const int idx = lo + i; if (idx <= hi) sm += ld4bf(ub + (size_t)idx * INC); }
#pragma unroll
            for (int tl = 0; tl < 8; ++tl) { const int tt = tt0 + tl;
                const int nlo = max(tt - ksz / 2, 0), nhi = min(tt + ksz - 1 - ksz / 2, L - 1);
                if (nhi > hi) { sm += ld4bf(ub + (size_t)nhi * INC); hi = nhi; }
                if (nlo > lo) { sm -= ld4bf(ub + (size_t)lo * INC); lo = nlo; }
                const f32x4 d = sm * (1.0f / (float)(hi - lo + 1)) - ld4bf(ub + (size_t)tt * INC);
                u32x2 w; w.x = cvt_pk_bf16(d[0], d[1]); w.y = cvt_pk_bf16(d[2], d[3]);
                *(u32x2*)(DP + (size_t)(sb + tt) * 512 + c) = w; }
            continue;
        }
        { const int c = tid;
          { const int c4 = (tid & 127) * 4;
#pragma unroll 8
            for (int rr = tid >> 7; rr < 62; rr += 4) { const int tt = t0 - sb - 15 + rr; f32x4 uv = {0.f, 0.f, 0.f, 0.f};
              if (tt >= 0 && tt < L) { const bf16_t* q = P + (size_t)(sb + tt) * INC + D_GLU + c4; const f32x4 a = ld4bf(q), g = ld4bf(q + 512);
                  uv = (f32x4){a[0] * sigmoidf_(g[0]), a[1] * sigmoidf_(g[1]), a[2] * sigmoidf_(g[2]), a[3] * sigmoidf_(g[3])}; }
              *(LAS f32x4*)(lu + rr * 512 + c4) = uv; } }
          __syncthreads();
          float w[31];
#pragma unroll
          for (int j = 0; j < 31; ++j) w[j] = p.conv_w[((size_t)l * 31 + j) * 512 + c];
          const float cb = p.conv_b[l * 512 + c];
          float y[32];
#pragma unroll
          for (int tl = 0; tl < 32; ++tl) { float a = cb;
#pragma unroll
              for (int j = 0; j < 31; ++j) a += lu[(tl + j) * 512 + c] * w[j];
              y[tl] = a; }
          __syncthreads();
#pragma unroll
          for (int tl = 0; tl < 32; ++tl) lu[tl * 512 + c] = y[tl];
          __syncthreads();
          for (int q = 0; q < 4; ++q) { const int tl = wid * 4 + q; float v[8]; float sm = 0.f;
#pragma unroll
              for (int i = 0; i < 8; ++i) { v[i] = lu[tl * 512 + i * 64 + lane]; sm += v[i]; }
              const float mu = wave_sum(sm) * (1.0f / 512.0f); float qq = 0.f;
#pragma unroll
              for (int i = 0; i < 8; ++i) { const float d = v[i] - mu; qq += d * d; }
              const float rstd = rsqrtf(wave_sum(qq) * (1.0f / 512.0f) + EPS);
#pragma unroll
              for (int i = 0; i < 8; ++i) { const int cc = i * 64 + lane; const float z = (v[i] - mu) * rstd * p.conv_ln_g[l * 512 + cc] + p.conv_ln_b[l * 512 + cc];
                  DLN[(size_t)(t0 + tl) * 512 + cc] = f2bf(siluf_(z)); } }
          __syncthreads(); }
    }
}

struct AttnUnit {
    const bf16_t* kbase; int kpitch;
    int qhead, tok0, ntiles, vth, gcol, ocol;
    int nband, nbp, rlo, kctx0;
    int rq, c0, rs, bh;
};
template <bool MASK>
__device__ __forceinline__ void attn_core(LAS unsigned char* lds, const Params& p, int l, const AttnUnit& a) {
    const int tid = opaque_tid(), lane = tid & 63, r = lane & 31, h2 = lane >> 5;
    const bf16_t* P = (const bf16_t*)(p.ws + WS_P); const bf16_t* QALL = (const bf16_t*)(p.ws + WS_QALL); const bf16_t* VT = (const bf16_t*)(p.ws + WS_VT); bf16_t* O = (bf16_t*)(p.ws + WS_O);
    LAS float* tab = (LAS float*)(lds + 65536);
    if (MASK) { for (int i = tid; i < 465; i += 512) tab[i] = p.na_rpb[((size_t)l * 8 + a.bh) * 465 + i] * LOG2E; }
    bf16x8 qf[4];
    { const bf16_t* qp = QALL + (size_t)(a.tok0 + r) * 1024 + a.qhead * 64 + 8 * h2;
#pragma unroll
      for (int ks = 0; ks < 4; ++ks) qf[ks] = *(const bf16x8*)(qp + 16 * ks); }
    const int lrow = tid >> 3, lch = tid & 7;
    const unsigned st_off = (unsigned)(lrow * 128 + ((lch ^ ((lrow >> 1) & 7)) << 4));
    const bf16_t* vrow = VT + ((size_t)a.vth * 64 + lrow) * MT + lch * 8;
    const bf16_t* krow = a.kbase + (size_t)lrow * a.kpitch + lch * 8;
#define KEY0(j) ((j) < a.nband ? (a.rlo + (j)) * 64 : ((j) < a.nbp ? a.rlo * 64 : a.kctx0 + ((j) - a.nbp) * 64))
    const int pr = (r & 19) | ((r & 4) << 1) | ((r & 8) >> 1);
    const unsigned ksw = (unsigned)((pr >> 1) & 7), vsw = (unsigned)((r >> 1) & 7);
    f32x16 o0, o1;
#pragma unroll
    for (int i = 0; i < 16; ++i) { o0[i] = 0.f; o1[i] = 0.f; }
    float m_run = 0.f, l_run = 0.f; bool started = false;
    const int nbig = a.ntiles >> 1;
    u32x4 kr[2], vr[2];
#define LOADB(J) { _Pragma("unroll") for (int u_ = 0; u_ < 2; ++u_) { const int k0_ = KEY0(2 * (J) + u_); kr[u_] = *(const u32x4*)(krow + (size_t)k0_ * a.kpitch); vr[u_] = *(const u32x4*)(vrow + k0_); } }
#define STOREB(slot) { LAS unsigned char* sb_ = lds + (slot) * 32768; _Pragma("unroll") for (int u_ = 0; u_ < 2; ++u_) { *(LAS u32x4*)(sb_ + u_ * 16384 + st_off) = kr[u_]; *(LAS u32x4*)(sb_ + u_ * 16384 + 8192 + st_off) = vr[u_]; } }
    LOADB(0); STOREB(0);
    __syncthreads();
    for (int J = 0; J < nbig; ++J) {
        const bool more = (J + 1 < nbig);
        if (more) LOADB(J + 1);
#pragma unroll
        for (int u = 0; u < 2; ++u) {
        const int j = 2 * J + u;
        bool active = true; int brow = 0;
        if (MASK) { if (j < a.nband) { const int kr_ = a.rlo + j; active = (kr_ >= a.rs) && (kr_ <= a.rs + 7); brow = kr_ - a.rq + 7; } else if (j < a.nbp) active = false; }
        if (active) {
            LAS unsigned char* Kb = lds + (J & 1) * 32768 + u * 16384; LAS unsigned char* Vb = Kb + 8192;
            bf16x8 kf[8];
#pragma unroll
            for (int ks = 0; ks < 4; ++ks) { const unsigned ch = (unsigned)(2 * ks + h2);
                kf[2 * ks] = *(const LAS bf16x8*)(Kb + pr * 128 + ((ch ^ ksw) << 4));
                kf[2 * ks + 1] = *(const LAS bf16x8*)(Kb + 4096 + pr * 128 + ((ch ^ ksw) << 4)); }
            const float negm = -m_run;
            f32x16 s0, s1;
#pragma unroll
            for (int i = 0; i < 16; ++i) { s0[i] = negm; s1[i] = negm; }
#pragma unroll
            for (int ks = 0; ks < 4; ++ks) {
                s0 = __builtin_amdgcn_mfma_f32_32x32x16_bf16(kf[2 * ks], qf[ks], s0, 0, 0, 0);
                s1 = __builtin_amdgcn_mfma_f32_32x32x16_bf16(kf[2 * ks + 1], qf[ks], s1, 0, 0, 0); }
            bf16x8 vf[8];
#pragma unroll
            for (int kt = 0; kt < 2; ++kt)
#pragma unroll
                for (int sx = 0; sx < 2; ++sx) { const unsigned ch = (unsigned)(4 * kt + 2 * sx + h2);
                    vf[(kt * 2 + sx) * 2] = *(const LAS bf16x8*)(Vb + r * 128 + ((ch ^ vsw) << 4));
                    vf[(kt * 2 + sx) * 2 + 1] = *(const LAS bf16x8*)(Vb + 4096 + r * 128 + ((ch ^ vsw) << 4)); }
            if (MASK) { if (j < a.nband) {
                const int cq = a.c0 + r, cs = clampi(cq - 8, 0, 48);
#pragma unroll
                for (int i = 0; i < 16; ++i) {
                    const int kc0 = 16 * (i >> 3) + 8 * h2 + 4 * ((i >> 2) & 1) + (i & 3), kc1 = kc0 + 32;
                    const bool v0 = (kc0 >= cs) && (kc0 < cs + 16), v1 = (kc1 >= cs) && (kc1 < cs + 16);
                    const float b0 = tab[brow * 31 + clampi(kc0 - cq + 15, 0, 30)], b1 = tab[brow * 31 + clampi(kc1 - cq + 15, 0, 30)];
                    s0[i] = v0 ? s0[i] + b0 : -1e30f; s1[i] = v1 ? s1[i] + b1 : -1e30f; } } }
            float mx = fmaxf(s0[0], s1[0]);
#pragma unroll
            for (int i = 1; i < 16; ++i) mx = fmaxf(fmaxf(mx, s0[i]), s1[i]);
            mx = fmaxf(mx, __shfl_xor(mx, 32));
            const bool slow = !started || (__builtin_amdgcn_ballot_w64(mx > 8.0f) != 0ull);
            if (slow) {
                const float delta = started ? fmaxf(mx, 0.f) : mx;
                const float alpha = fexp2(-delta);
#pragma unroll
                for (int i = 0; i < 16; ++i) { s0[i] -= delta; s1[i] -= delta; o0[i] *= alpha; o1[i] *= alpha; }
                l_run *= alpha; m_run += delta;
            }
            started = true;
            typedef float f32x2_ __attribute__((ext_vector_type(2)));
            f32x2_ acc2 = {0.f, 0.f};
#pragma unroll
            for (int i = 0; i < 16; ++i) { s0[i] = fexp2(s0[i]); s1[i] = fexp2(s1[i]); }
#pragma unroll
            for (int i = 0; i < 8; ++i) { acc2 += (f32x2_){s0[2 * i], s0[2 * i + 1]}; acc2 += (f32x2_){s1[2 * i], s1[2 * i + 1]}; }
            l_run += acc2.x + acc2.y;
            bf16x8 pb[2][2];
#pragma unroll
            for (int sx = 0; sx < 2; ++sx) {
                u32x4 w0, w1;
                w0.x = cvt_pk_bf16(s0[8 * sx + 0], s0[8 * sx + 1]); w0.y = cvt_pk_bf16(s0[8 * sx + 2], s0[8 * sx + 3]); w0.z = cvt_pk_bf16(s0[8 * sx + 4], s0[8 * sx + 5]); w0.w = cvt_pk_bf16(s0[8 * sx + 6], s0[8 * sx + 7]);
                w1.x = cvt_pk_bf16(s1[8 * sx + 0], s1[8 * sx + 1]); w1.y = cvt_pk_bf16(s1[8 * sx + 2], s1[8 * sx + 3]); w1.z = cvt_pk_bf16(s1[8 * sx + 4], s1[8 * sx + 5]); w1.w = cvt_pk_bf16(s1[8 * sx + 6], s1[8 * sx + 7]);
                pb[0][sx] = __builtin_bit_cast(bf16x8, w0); pb[1][sx] = __builtin_bit_cast(bf16x8, w1); }
#pragma unroll
            for (int kt = 0; kt < 2; ++kt)
#pragma unroll
                for (int sx = 0; sx < 2; ++sx) {
                    o0 = __builtin_amdgcn_mfma_f32_32x32x16_bf16(vf[(kt * 2 + sx) * 2], pb[kt][sx], o0, 0, 0, 0);
                    o1 = __builtin_amdgcn_mfma_f32_32x32x16_bf16(vf[(kt * 2 + sx) * 2 + 1], pb[kt][sx], o1, 0, 0, 0); }
        }
        }
        if (more) STOREB((J + 1) & 1);
        __syncthreads();
    }
#undef KEY0
#undef LOADB
#undef STOREB
    { const float lt = l_run + __shfl_xor(l_run, 32); const float inv = 1.0f / lt; const size_t tok = (size_t)(a.tok0 + r);
#pragma unroll
      for (int dt = 0; dt < 2; ++dt)
#pragma unroll
          for (int g4 = 0; g4 < 4; ++g4) { const int dim = dt * 32 + 8 * g4 + 4 * h2;
              const u32x2 gw = *(const u32x2*)(P + tok * INC + a.gcol + dim);
              const float e0 = (dt ? o1[4 * g4 + 0] : o0[4 * g4 + 0]) * inv * siluf_(lo_bf(gw.x)), e1 = (dt ? o1[4 * g4 + 1] : o0[4 * g4 + 1]) * inv * siluf_(hi_bf(gw.x));
              const float e2 = (dt ? o1[4 * g4 + 2] : o0[4 * g4 + 2]) * inv * siluf_(lo_bf(gw.y)), e3 = (dt ? o1[4 * g4 + 3] : o0[4 * g4 + 3]) * inv * siluf_(hi_bf(gw.y));
              u32x2 w; w.x = cvt_pk_bf16(e0, e1); w.y = cvt_pk_bf16(e2, e3);
              *(u32x2*)(O + tok * DM + a.ocol + dim) = w; } }
}

__device__ void phase_mix(const Params& p, LAS unsigned char* lds, int l, int bid, int nb) {
    const int wid = __builtin_amdgcn_readfirstlane(opaque_tid() >> 6);
    const bf16_t* P = (const bf16_t*)(p.ws + WS_P); const bf16_t* KC = (const bf16_t*)(p.ws + WS_KC);
    const int nunits = (l == DEPTH - 1) ? 512 : 528;
    for (int u = bid; u < nunits; u += nb) {
        AttnUnit a;
        if (u < 256 || (u >= 512 && u < 520)) {
            const bool cx = u >= 512; const int uu = cx ? u - 512 : u; const int kvh = uu & 1, tb = uu >> 1, hq = kvh * 4 + (wid & 3);
            a.kbase = KC + kvh * 64; a.kpitch = 128; a.qhead = 8 + hq; a.tok0 = (cx ? SEQ : 0) + tb * 64 + (wid >> 2) * 32; a.ntiles = cx ? 4 : 132; a.vth = 8 + kvh;
            a.gcol = C_G + hq * 64; a.ocol = 1024 + hq * 64; a.nband = 0; a.nbp = 0; a.rlo = 0; a.kctx0 = cx ? SEQ : 0; a.rq = 0; a.c0 = 0; a.rs = 0; a.bh = 0;
            attn_core<false>(lds, p, l, a);
        } else if (u >= 520) {
            const int h = u - 520;
            a.kbase = P + A_K + h * 64; a.kpitch = INC; a.qhead = h; a.tok0 = SEQ + wid * 32; a.ntiles = 4; a.vth = h; a.gcol = A_G + h * 64; a.ocol = h * 64;
            a.nband = 0; a.nbp = 0; a.rlo = 0; a.kctx0 = SEQ; a.rq = 0; a.c0 = 0; a.rs = 0; a.bh = 0;
            attn_core<false>(lds, p, l, a);
        } else {
            const int uu = u - 256, h = uu & 7, rg = uu >> 3, rq0 = rg * 4;
            a.kbase = P + A_K + h * 64; a.kpitch = INC; a.qhead = h; a.rq = rq0 + (wid >> 1); a.c0 = (wid & 1) * 32; a.tok0 = a.rq * 64 + a.c0; a.vth = h; a.gcol = A_G + h * 64; a.ocol = h * 64;
            a.rlo = clampi(rq0 - 4, 0, 120); const int rhi = clampi(rq0 + 3 - 4, 0, 120) + 7; a.nband = rhi - a.rlo + 1; a.nbp = (a.nband + 1) & ~1; a.ntiles = a.nbp + 4; a.kctx0 = SEQ; a.rs = clampi(a.rq - 4, 0, 120); a.bh = h;
            attn_core<true>(lds, p, l, a);
        }
    }
    __syncthreads();
    { pg8::Gemm g{(const bf16_t*)(p.ws + WS_DLN), (const bf16_t*)(p.ws + WS_WPW) + (size_t)l * 512 * 512, 512, 512, 512, (size_t)MT * 512, (size_t)DEPTH * 512 * 512};
      pg8::SmallOrder S{nb, (bid + nb - (nunits % nb)) % nb};
      pg8::EpiSmall E{(bf16_t*)(p.ws + WS_O), P, p.pool_scale + (size_t)l * 512};
      pg8::gemm_phase<pg8::EpiSmall, pg8::SmallOrder>(lds, g, S, E); }
    if (l != DEPTH - 1) {
      pg8::Gemm g{(const bf16_t*)(p.ws + WS_H), (const bf16_t*)(p.ws + WS_WIN) + (size_t)l * INC * DM, DM, DM, DM, 0, 0};
      pg8::CtxColsOrder S{nb, (bid + nb - 148) % nb};
      pg8::EpiStoreBf16 E{(bf16_t*)(p.ws + WS_P), INC};
      pg8::gemm_phase<pg8::EpiStoreBf16, pg8::CtxColsOrder>(lds, g, S, E); }
}

__device__ __forceinline__ unsigned xcc_id() { return (unsigned)__builtin_amdgcn_s_getreg((3 << 11) | 20) & 0xFu; }
__device__ __forceinline__ void grid_bar(unsigned* ctl, unsigned& epoch, unsigned x, unsigned nloc, unsigned nx) {
    asm volatile("s_waitcnt vmcnt(0) lgkmcnt(0)" ::: "memory");
    __syncthreads();
    epoch += 1;
    if (threadIdx.x == 0) {
        const unsigned old = __hip_atomic_fetch_add(ctl + 96 + 32 * x, 1u, __ATOMIC_RELAXED, __HIP_MEMORY_SCOPE_AGENT);
        if (old + 1u == epoch * nloc) {
            __builtin_amdgcn_fence(__ATOMIC_RELEASE, "");
            asm volatile("s_waitcnt vmcnt(0)" ::: "memory");
            const unsigned old2 = __hip_atomic_fetch_add(ctl + 64, 1u, __ATOMIC_RELAXED, __HIP_MEMORY_SCOPE_AGENT);
            if (old2 + 1u == epoch * nx) __hip_atomic_store(ctl + 32, epoch, __ATOMIC_RELAXED, __HIP_MEMORY_SCOPE_AGENT);
        }
        while (__hip_atomic_load(ctl + 32, __ATOMIC_RELAXED, __HIP_MEMORY_SCOPE_AGENT) < epoch) __builtin_amdgcn_s_sleep(2);
        __builtin_amdgcn_fence(__ATOMIC_ACQUIRE, "");
        asm volatile("s_waitcnt vmcnt(0) lgkmcnt(0)" ::: "memory");
    }
    __syncthreads();
}
#define GSYNC() grid_bar(gctr, epoch, xcc, nloc, nxcc)

template <bool MRG>
__device__ __forceinline__ void ctx_tail(LAS unsigned char* lds, const Params& p, int l, int bid, int nb) {
    const int tid = opaque_tid(), wid = tid >> 6, lane = tid & 63, r = lane & 31, h = lane >> 5;
    LAS float* part = (LAS float*)lds;
    const bf16_t* P = (const bf16_t*)(p.ws + WS_P);
    const bf16_t* Asrc = MRG ? (const bf16_t*)(p.ws + WS_O) : (const bf16_t*)(p.ws + WS_Y1);
    const bf16_t* Bsrc = (MRG ? (const bf16_t*)(p.ws + WS_WBR) : (const bf16_t*)(p.ws + WS_WOUT)) + (size_t)l * DM * DM;
    constexpr int NTAG = MRG ? 4 : 1, KQ = MRG ? 128 : 512;
    for (int blk = bid; blk < 256; blk += nb) {
        const int rg = blk & 3, cg = blk >> 2, rh = wid & 1, kq = wid >> 1;
        const int row0 = SEQ + rg * 64 + rh * 32, col0 = cg * 32;
        const bf16_t* A = Asrc + (size_t)(row0 + r) * DM + 8 * h;
        const bf16_t* B = Bsrc + (size_t)(col0 + r) * DM + 8 * h;
        f32x16 tot;
#pragma unroll
        for (int i = 0; i < 16; ++i) tot[i] = 0.f;
#pragma unroll 1
        for (int b = 0; b < NTAG; ++b) {
            f32x16 acc;
#pragma unroll
            for (int i = 0; i < 16; ++i) acc[i] = 0.f;
            const int kbase = MRG ? b * 512 + kq * 128 : kq * 512;
#pragma unroll 8
            for (int ks = 0; ks < KQ / 16; ++ks) {
                const bf16x8 af = *(const bf16x8*)(A + kbase + ks * 16);
                const bf16x8 bf = *(const bf16x8*)(B + kbase + ks * 16);
                acc = __builtin_amdgcn_mfma_f32_32x32x16_bf16(bf, af, acc, 0, 0, 0);
            }
            if (MRG) {
#pragma unroll
                for (int g4 = 0; g4 < 4; ++g4) { const int c = col0 + 8 * g4 + 4 * h;
                    const u32x2 gw = *(const u32x2*)(P + (size_t)(row0 + r) * INC + MERGE + b * DM + c);
                    tot[4 * g4 + 0] += acc[4 * g4 + 0] * sigmoidf_(lo_bf(gw.x)); tot[4 * g4 + 1] += acc[4 * g4 + 1] * sigmoidf_(hi_bf(gw.x));
                    tot[4 * g4 + 2] += acc[4 * g4 + 2] * sigmoidf_(lo_bf(gw.y)); tot[4 * g4 + 3] += acc[4 * g4 + 3] * sigmoidf_(hi_bf(gw.y)); }
            } else tot = acc;
        }
#pragma unroll
        for (int i = 0; i < 16; ++i) part[((kq * 2 + rh) * 16 + i) * 64 + lane] = tot[i];
        __syncthreads();
        float v[4];
#pragma unroll
        for (int e = 0; e < 4; ++e) { float a = 0.f;
#pragma unroll
            for (int q = 0; q < 4; ++q) a += part[((q * 2 + rh) * 16 + 4 * kq + e) * 64 + lane];
            v[e] = a; }
        const size_t row = (size_t)(row0 + r); const int c = col0 + 8 * kq + 4 * h;
        if (MRG) { u32x2 w; w.x = cvt_pk_bf16(v[0], v[1]); w.y = cvt_pk_bf16(v[2], v[3]); *(u32x2*)((bf16_t*)(p.ws + WS_Y1) + row * DM + c) = w; }
        else *(f32x4*)((float*)(p.ws + WS_Y) + row * DM + c) = (f32x4){v[0], v[1], v[2], v[3]};
        __syncthreads();
    }
}

__device__ __forceinline__ void run_phase(const Params& p, LAS unsigned char* lds, int ph, int bid0, int nb0) {
    const int bid = opaque_s(bid0), nb = opaque_s(nb0);
    if (ph == 0) { phase0(p, lds, bid, nb); return; }
    if (ph == 1) { phase_rows(p, -1, bid, nb); return; }
    const int l = opaque_s((ph - 2) / 6), q = (ph - 2) % 6;
    if (q == 0) {
        pg8::Gemm g{(const bf16_t*)(p.ws + WS_H), (const bf16_t*)(p.ws + WS_WIN) + (size_t)l * INC * DM, DM, DM, DM, 0, 0};
        pg8::StaticOrder S; S.init(SEQ, INC, nb, bid, l == DEPTH - 1 ? 5 : 32);
        pg8::EpiStoreBf16 E{(bf16_t*)(p.ws + WS_P), INC};
        pg8::gemm_phase<pg8::EpiStoreBf16, pg8::StaticOrder>(lds, g, S, E);
    } else if (q == 1) phase_prep(p, lds, l, bid, nb);
    else if (q == 2) phase_mix(p, lds, l, bid, nb);
    else if (q == 3) {
        pg8::Gemm g{(const bf16_t*)(p.ws + WS_O), (const bf16_t*)(p.ws + WS_WBR) + (size_t)l * DM * DM, DM, DM, 512, 512, 512};
        pg8::TagOrder<4> S; S.init(SEQ, DM, nb, bid);
        pg8::EpiMerge E{(bf16_t*)(p.ws + WS_Y1), (const bf16_t*)(p.ws + WS_P)};
        pg8::gemm_phase<pg8::EpiMerge, pg8::TagOrder<4>>(lds, g, S, E);
        if (l != DEPTH - 1) ctx_tail<true>(lds, p, l, bid, nb);
    } else if (q == 4) {
        pg8::Gemm g{(const bf16_t*)(p.ws + WS_Y1), (const bf16_t*)(p.ws + WS_WOUT) + (size_t)l * DM * DM, DM, DM, DM, 0, 0};
        pg8::StaticOrder S; S.init(SEQ, DM, nb, bid);
        pg8::EpiF32 E{(float*)(p.ws + WS_Y), DM};
        pg8::gemm_phase<pg8::EpiF32, pg8::StaticOrder>(lds, g, S, E);
        if (l != DEPTH - 1) ctx_tail<false>(lds, p, l, bid, nb);
    } else phase_rows(p, l, bid, nb);
}
constexpr int NPHASES = 2 + 6 * DEPTH;
#ifndef N_LAUNCH_MODE
#define N_LAUNCH_MODE 1
#endif
__global__ void __launch_bounds__(512) mega_fwd(Params p, int ph_lo, int ph_hi) {
    extern __shared__ __attribute__((aligned(16))) unsigned char shm_raw[];
    LAS unsigned char* lds = (LAS unsigned char*)shm_raw;
    const int bid = blockIdx.x, nb = gridDim.x;
    unsigned* gctr = (unsigned*)(p.ws + WS_CTL); unsigned epoch = 0;
    const unsigned xcc = (unsigned)__builtin_amdgcn_readfirstlane((int)xcc_id());
    unsigned nloc = 1, nxcc = 1;
    if (N_LAUNCH_MODE == 1) {
        if (threadIdx.x == 0) __hip_atomic_fetch_add(gctr + xcc, 1u, __ATOMIC_RELAXED, __HIP_MEMORY_SCOPE_AGENT);
        cg::grid_group grid = cg::this_grid(); grid.sync();
        nloc = __hip_atomic_load(gctr + xcc, __ATOMIC_RELAXED, __HIP_MEMORY_SCOPE_AGENT); nxcc = 0;
#pragma unroll
        for (int j = 0; j < 16; ++j) nxcc += (__hip_atomic_load(gctr + j, __ATOMIC_RELAXED, __HIP_MEMORY_SCOPE_AGENT) != 0u) ? 1u : 0u;
        nloc = (unsigned)__builtin_amdgcn_readfirstlane((int)nloc); nxcc = (unsigned)__builtin_amdgcn_readfirstlane((int)nxcc);
    }
    for (int ph0 = ph_lo; ph0 < ph_hi; ++ph0) {
        const int ph = opaque_s(ph0);
        run_phase(p, lds, ph, bid, nb);
        if (ph0 + 1 < ph_hi) GSYNC();
    }
}

extern "C" void kernel_launch(void* const* d_in, const int* in_sizes, int n_in, void* d_out, int out_size, void* d_ws, size_t ws_size, hipStream_t stream) {
    static int grid = 0;
    if (grid == 0) {
        if (n_in != 21 || ws_size < WS_END) { fprintf(stderr, "kernel_launch: unexpected inputs (%d) or workspace (%zu < %zu)\n", n_in, ws_size, (size_t)WS_END); grid = -1; return; }
        int dev = 0, cus = 0, per_cu = 0;
        (void)hipGetDevice(&dev); (void)hipDeviceGetAttribute(&cus, hipDeviceAttributeMultiprocessorCount, dev);
        if (hipFuncSetAttribute((const void*)mega_fwd, hipFuncAttributeMaxDynamicSharedMemorySize, LDS_BYTES) != hipSuccess) { fprintf(stderr, "kernel_launch: hipFuncSetAttribute failed\n"); grid = -1; return; }
        if (hipOccupancyMaxActiveBlocksPerMultiprocessor(&per_cu, (const void*)mega_fwd, 512, LDS_BYTES) != hipSuccess || per_cu < 1) { fprintf(stderr, "kernel_launch: occupancy query says %d\n", per_cu); per_cu = 1; }
        (void)hipGetLastError();
        grid = cus * 1;
        if (grid <= 0) grid = 256;
    }
    if (grid < 0) return;
    Params p{};
    const float** pp = (const float**)&p;
    for (int i = 0; i < 21; ++i) pp[i] = (const float*)d_in[i];
    p.out = (float*)d_out; p.ws = (unsigned char*)d_ws;
    if (hipMemsetAsync((unsigned char*)d_ws + WS_CTL, 0, 4096, stream) != hipSuccess) { fprintf(stderr, "kernel_launch: memset of the barrier word failed\n"); return; }
    hipError_t e = hipSuccess;
    if (N_LAUNCH_MODE == 1) { int lo = 0, hi = NPHASES; void* args[] = {&p, &lo, &hi};
        e = hipLaunchCooperativeKernel((const void*)mega_fwd, dim3(grid), dim3(512), args, LDS_BYTES, stream); }
    else { for (int ph = 0; ph < NPHASES; ++ph) hipLaunchKernelGGL(mega_fwd, dim3(grid), dim3(512), LDS_BYTES, stream, p, ph, ph + 1); e = hipGetLastError(); }
    if (e != hipSuccess) fprintf(stderr, "kernel_launch: cooperative launch failed: %s (grid %d)\n", hipGetErrorString(e), grid);
}
```

```cpp
#include <hip/hip_runtime.h>
#include <hip/hip_cooperative_groups.h>
#include <cstdio>
#include <cstdint>
namespace cg = cooperative_groups;

#define LAS __attribute__((address_space(3)))
typedef unsigned short bf16_t;
typedef short bf16x8 __attribute__((ext_vector_type(8)));
typedef float f32x4 __attribute__((ext_vector_type(4)));
typedef float f32x16 __attribute__((ext_vector_type(16)));
typedef unsigned u32x4 __attribute__((ext_vector_type(4)));
typedef unsigned u32x2 __attribute__((ext_vector_type(2)));

constexpr int DM = 2048, SEQ = 8192, NCTX = 256, MT = SEQ + NCTX, DEPTH = 4, INC = 14080;
constexpr int A_K = 0, A_V = 512, C_K = 1024, C_V = 1152, A_Q = 1280, C_Q = 1792, A_G = 2304, B_IN = 2816, B_G = 3328, C_G = 3840, D_GLU = 4352, D_G = 5376, MERGE = 5888;
constexpr float EPS = 1e-6f, LOG2E = 1.4426950408889634f, QS = 0.125f * 1.4426950408889634f;

constexpr size_t al256(size_t x) { return (x + 255) & ~(size_t)255; }
constexpr size_t WS_WIN = 0;
constexpr size_t WS_WBR = al256(WS_WIN + (size_t)DEPTH * INC * DM * 2);
constexpr size_t WS_WOUT = al256(WS_WBR + (size_t)DEPTH * DM * DM * 2);
constexpr size_t WS_WPW = al256(WS_WOUT + (size_t)DEPTH * DM * DM * 2);
constexpr size_t WS_WPOOL = WS_WPW + (size_t)DEPTH * 512 * 512 * 2;
constexpr size_t WS_MOD = al256(WS_WPOOL + (size_t)DEPTH * 512 * 512 * 2);
constexpr size_t WS_ROPE = al256(WS_MOD + (size_t)DEPTH * 2 * 6144 * 4);
constexpr size_t WS_H = al256(WS_ROPE + 2 * 128 * 16 * 4);
constexpr size_t WS_P = al256(WS_H + (size_t)MT * DM * 2);
constexpr size_t WS_QALL = al256(WS_P + (size_t)MT * INC * 2);
constexpr size_t WS_KC = al256(WS_QALL + (size_t)MT * 1024 * 2);
constexpr size_t WS_VT = al256(WS_KC + (size_t)MT * 128 * 2);
constexpr size_t WS_DLN = al256(WS_VT + (size_t)10 * 64 * MT * 2);
constexpr size_t WS_DP = WS_DLN + (size_t)MT * 512 * 2;
constexpr size_t WS_O = al256(WS_DP + (size_t)MT * 512 * 2);
constexpr size_t WS_YACC = al256(WS_O + (size_t)MT * DM * 2);
constexpr size_t WS_Y1 = al256(WS_YACC + (size_t)MT * DM * 4);
constexpr size_t WS_Y = al256(WS_Y1 + (size_t)MT * DM * 2);
constexpr size_t WS_X = al256(WS_Y + (size_t)MT * DM * 4);
constexpr size_t WS_CTL = al256(WS_X + (size_t)MT * DM * 4);
constexpr size_t WS_END = WS_CTL + 4096;

constexpr int LDS_BYTES = 131072;
#define N_LAUNCH_MODE 1
#define ZERO_LO WS_H
#define ZERO_HI WS_CTL

struct Params {
    const float *x, *c, *ctx, *c_ctx, *w_ada, *b_ada, *g_pre, *g_post, *w_in, *na_rpb, *pool_w, *pool_scale, *q_norm, *k_norm, *conv_w, *conv_b, *conv_ln_g, *conv_ln_b, *conv_pw, *w_branch, *w_out;
    float* out; unsigned char* ws;
};

__device__ __forceinline__ float bf2f(bf16_t b) { return __uint_as_float(((unsigned)b) << 16); }
__device__ __forceinline__ unsigned cvt_pk_bf16(float lo, float hi) { unsigned r; asm volatile("v_cvt_pk_bf16_f32 %0, %1, %2" : "=v"(r) : "v"(lo), "v"(hi)); return r; }
__device__ __forceinline__ bf16_t f2bf(float f) { return (bf16_t)(cvt_pk_bf16(f, 0.f) & 0xffffu); }
__device__ __forceinline__ float fexp2(float x) { return __builtin_amdgcn_exp2f(x); }
__device__ __forceinline__ float sigmoidf_(float x) { return __builtin_amdgcn_rcpf(1.0f + fexp2(-x * LOG2E)); }
__device__ __forceinline__ float siluf_(float x) { return x * sigmoidf_(x); }
__device__ __forceinline__ float wave_sum(float v) { v += __shfl_xor(v, 32); v += __shfl_xor(v, 16); v += __shfl_xor(v, 8); v += __shfl_xor(v, 4); v += __shfl_xor(v, 2); v += __shfl_xor(v, 1); return v; }
__device__ __forceinline__ float lo_bf(unsigned w) { return __uint_as_float(w << 16); }
__device__ __forceinline__ float hi_bf(unsigned w) { return __uint_as_float(w & 0xffff0000u); }
__device__ __forceinline__ f32x4 ld4bf(const bf16_t* q) { const u32x2 w = *(const u32x2*)q; return (f32x4){lo_bf(w.x), hi_bf(w.x), lo_bf(w.y), hi_bf(w.y)}; }
__device__ __forceinline__ int clampi(int v, int lo, int hi) { return v < lo ? lo : (v > hi ? hi : v); }
__device__ __forceinline__ int opaque_tid() { int t = threadIdx.x; asm volatile("" : "+v"(t)); return t; }
__device__ __forceinline__ int opaque_s(int v) { asm volatile("" : "+s"(v)); return v; }

namespace pg8 {
constexpr int BM = 256, BK = 64, HALF = 128, HTB = HALF * BK * 2, STAGE_BYTES = 8 * HTB, NXCD = 8, WGM = 8;
__host__ __device__ __forceinline__ int lds_byte(int r, int c) { const int st = (r >> 4) * 2 + (c >> 5), rr = r & 15, cc = c & 31, ob = rr * 64 + cc * 2; return st * 1024 + (ob ^ (((ob >> 9) & 1) << 5)); }
__host__ __device__ __forceinline__ void stage_rc(int b, int& R, int& C) { const int st = b / 1024, sb = b % 1024, swz = sb ^ (((sb >> 9) & 1) << 5); R = (st >> 1) * 16 + swz / 64; C = (st & 1) * 32 + (swz % 64) / 2; }
__host__ __device__ __forceinline__ int perm32(int rho) { const int n = rho >> 4, i = rho & 15; return 8 * (i >> 2) + 4 * n + (i & 3); }

struct Unit { int pm, pn, tag; };
struct Gemm { const bf16_t* A; const bf16_t* Bt; int lda, ldb, K; size_t a_tag, b_tag; };

struct StaticOrder {
    int nM, nN, nwg, G, c, extra;
    __device__ void init(int M, int N, int G_, int c_, int extra_ = 0) { nM = M / BM; nN = N / BM; nwg = nM * nN; G = G_; c = c_; extra = extra_; }
    __device__ bool tile(long L, Unit& u) const {
        if (L >= nwg) { if (L >= nwg + extra) return false; u.pm = nM; u.pn = (int)(L - nwg); u.tag = 0; return true; }
        int wgid = (int)L; { const int q = nwg / NXCD, r = nwg % NXCD, xcd = wgid % NXCD, off = wgid / NXCD; wgid = (xcd < r ? xcd * (q + 1) : r * (q + 1) + (xcd - r) * q) + off; }
        const int nig = WGM * nN, gid = wgid / nig, fm = gid * WGM, gsz = (nM - fm) < WGM ? (nM - fm) : WGM;
        u.pm = fm + ((wgid % nig) % gsz); u.pn = (wgid % nig) / gsz; u.tag = 0; return true;
    }
    __device__ bool next(int i, Unit& u) const { return tile((long)i * G + c, u); }
};
template <int NT> struct TagOrder : StaticOrder {
    __device__ bool next(int i, Unit& u) const { if (!tile((long)(i / NT) * G + c, u)) return false; u.tag = i % NT; return true; }
};
struct SmallOrder {
    int G, c;
    __device__ bool next(int i, Unit& u) const { const int L = i * G + c; if (L >= 132) return false; u.tag = L / 66; const int rem = L % 66; u.pm = rem >> 1; u.pn = rem & 1; return true; }
};

struct CtxColsOrder {
    int G, c;
    __device__ bool next(int i, Unit& u) const { const int L = i * G + c; if (L >= 23) return false; u.pm = 32; u.pn = 32 + L; u.tag = 0; return true; }
};

template <class Epi, class Sched>
__device__ __forceinline__ void gemm_phase(LAS unsigned char* lds, const Gemm g, const Sched& S, const Epi& E) {
    const int tid = opaque_tid(), wid = __builtin_amdgcn_readfirstlane(tid >> 6), lane = tid & 63, wr = wid >> 2, wc = wid & 3, fr = lane & 15, fq = lane >> 4;
    const int nt = g.K / BK;
    unsigned voffA[2], voffB[2];
#pragma unroll
    for (int i = 0; i < 2; ++i) { int R, C; stage_rc(tid * 16 + i * 8192, R, C); const int Rb = Epi::PERM ? ((R & ~31) + perm32(R & 31)) : R;
        voffA[i] = (unsigned)(R * g.lda + C) * 2u; voffB[i] = (unsigned)(Rb * g.ldb + C) * 2u; }
    const size_t kstep = (size_t)(BK * 2);
    const size_t hstepA = (size_t)HALF * g.lda * 2, hstepB = (size_t)HALF * g.ldb * 2;
    const unsigned ldsw = (unsigned)wid * 1024u;
    const int aoff = lds_byte(wr * 64 + fr, fq * 8), boff = lds_byte(wc * 32 + fr, fq * 8);
#define PG8_UA(u) ((const char*)g.A + ((size_t)(u).pm * BM * g.lda + (size_t)(u).tag * g.a_tag) * 2)
#define PG8_UB(u) ((const char*)g.Bt + ((size_t)(u).pn * BM * g.ldb + (size_t)(u).tag * g.b_tag) * 2)
#define PG8_SA(b, h) (((b) * 2 + (h)) * HTB)
#define PG8_SB(b, h) ((4 + (b) * 2 + (h)) * HTB)
#define PG8_STAGE(bufoff, gbase, voff) do { _Pragma("unroll") for (int _i = 0; _i < 2; ++_i) \
        __builtin_amdgcn_global_load_lds((const unsigned*)((const char*)(gbase) + (voff)[_i]), (LAS unsigned*)(lds + (bufoff) + ldsw + _i * 8192), 16, 0, 0); } while (0)
#define PG8_LDA(dst, b, h) do { _Pragma("unroll") for (int m = 0; m < 4; ++m) _Pragma("unroll") for (int k = 0; k < 2; ++k) dst[m][k] = *(const LAS bf16x8*)(lds + PG8_SA(b, h) + aoff + m * 2048 + k * 1024); } while (0)
#define PG8_LDB(dst, b, h) do { _Pragma("unroll") for (int n = 0; n < 2; ++n) _Pragma("unroll") for (int k = 0; k < 2; ++k) dst[n][k] = *(const LAS bf16x8*)(lds + PG8_SB(b, h) + boff + n * 2048 + k * 1024); } while (0)
#define PG8_MMA(ai, bj, At, Bt) do { __builtin_amdgcn_s_setprio(1); _Pragma("unroll") for (int m = 0; m < 4; ++m) _Pragma("unroll") for (int n = 0; n < 2; ++n) _Pragma("unroll") for (int k = 0; k < 2; ++k) \
        acc[ai][bj][m][n] = __builtin_amdgcn_mfma_f32_16x16x32_bf16(Bt[n][k], At[m][k], acc[ai][bj][m][n], 0, 0, 0); __builtin_amdgcn_s_setprio(0); } while (0)
#define PG8_WAIT_V(n) asm volatile("s_waitcnt vmcnt(" #n ")" ::: "memory")
#define PG8_WAIT_L(n) asm volatile("s_waitcnt lgkmcnt(" #n ")" ::: "memory")
#define PG8_BAR __builtin_amdgcn_s_barrier()
#define PG8_SCHED __builtin_amdgcn_sched_barrier(0)
    Unit cur, nxt; int ui = 0;
    if (!S.next(0, cur)) return;
    f32x4 acc[2][2][4][2];
#pragma unroll
    for (int a = 0; a < 2; ++a)
#pragma unroll
        for (int b = 0; b < 2; ++b)
#pragma unroll
            for (int m = 0; m < 4; ++m)
#pragma unroll
                for (int n = 0; n < 2; ++n) acc[a][b][m][n] = (f32x4){0.f, 0.f, 0.f, 0.f};
    bf16x8 At[4][2], B0[2][2], B1[2][2];
    const char* cA = PG8_UA(cur); const char* cB = PG8_UB(cur);
    PG8_STAGE(PG8_SB(0, 0), cB, voffB); PG8_STAGE(PG8_SB(0, 1), cB + hstepB, voffB); PG8_STAGE(PG8_SA(0, 0), cA, voffA); PG8_STAGE(PG8_SA(0, 1), cA + hstepA, voffA);
    if (wr == 1) PG8_BAR;
    PG8_WAIT_V(2); PG8_BAR;
    PG8_STAGE(PG8_SB(1, 0), cB + kstep, voffB); PG8_STAGE(PG8_SA(1, 0), cA + kstep, voffA); PG8_STAGE(PG8_SB(1, 1), cB + hstepB + kstep, voffB);
    PG8_WAIT_V(6); PG8_BAR;
    for (;;) {
        const bool has_next = S.next(ui + 1, nxt);
        const char* nA = has_next ? PG8_UA(nxt) : cA; const char* nB = has_next ? PG8_UB(nxt) : cB;
        for (int t = 0; t < nt; t += 2) {
            const bool last = (t == nt - 2);
            const char* a1 = cA + (size_t)(t + 1) * kstep;
            const char* a2 = last ? nA : cA + (size_t)(t + 2) * kstep; const char* b2 = last ? nB : cB + (size_t)(t + 2) * kstep;
            const char* a3 = a2 + kstep; const char* b3 = b2 + kstep;
            PG8_LDB(B0, 0, 0); PG8_LDB(B1, 0, 1); PG8_SCHED; PG8_LDA(At, 0, 0); PG8_STAGE(PG8_SA(1, 1), a1 + hstepA, voffA);
            PG8_WAIT_V(8); PG8_WAIT_L(0); PG8_BAR; PG8_MMA(0, 0, At, B0); PG8_MMA(0, 1, At, B1); PG8_BAR; PG8_SCHED;
            PG8_LDA(At, 0, 1); PG8_STAGE(PG8_SB(0, 0), b2, voffB); PG8_STAGE(PG8_SB(0, 1), b2 + hstepB, voffB); PG8_STAGE(PG8_SA(0, 0), a2, voffA);
            PG8_WAIT_V(8); PG8_WAIT_L(0); PG8_BAR; PG8_MMA(1, 0, At, B0); PG8_MMA(1, 1, At, B1); PG8_BAR; PG8_SCHED;
            PG8_LDB(B0, 1, 0); PG8_LDB(B1, 1, 1); PG8_SCHED; PG8_LDA(At, 1, 0); PG8_STAGE(PG8_SA(0, 1), a2 + hstepA, voffA);
            PG8_WAIT_V(8); PG8_WAIT_L(0); PG8_BAR; PG8_MMA(0, 0, At, B0); PG8_MMA(0, 1, At, B1); PG8_BAR; PG8_SCHED;
            PG8_LDA(At, 1, 1); PG8_STAGE(PG8_SB(1, 0), b3, voffB); PG8_STAGE(PG8_SB(1, 1), b3 + hstepB, voffB); PG8_STAGE(PG8_SA(1, 0), a3, voffA);
            PG8_WAIT_V(8); PG8_WAIT_L(0); PG8_BAR; PG8_MMA(1, 0, At, B0); PG8_MMA(1, 1, At, B1); PG8_BAR; PG8_SCHED;
        }
        if (wr == 0) PG8_BAR;
        E(acc, cur, wr, wc, fr, fq);
        if (!has_next) break;
        if (!(Epi::CHAIN && cur.tag != Epi::LAST_TAG)) {
#pragma unroll
        for (int a = 0; a < 2; ++a)
#pragma unroll
            for (int b = 0; b < 2; ++b)
#pragma unroll
                for (int m = 0; m < 4; ++m)
#pragma unroll
                    for (int n = 0; n < 2; ++n) acc[a][b][m][n] = (f32x4){0.f, 0.f, 0.f, 0.f};
        }
        cur = nxt; cA = nA; cB = nB; ++ui;
        if (wr == 1) PG8_BAR;
    }
    PG8_WAIT_V(0);
    PG8_BAR;
#undef PG8_UA
#undef PG8_UB
#undef PG8_SA
#undef PG8_SB
#undef PG8_STAGE
#undef PG8_LDA
#undef PG8_LDB
#undef PG8_MMA
#undef PG8_WAIT_V
#undef PG8_WAIT_L
#undef PG8_BAR
#undef PG8_SCHED
}

struct EpiStoreBf16 {
    static constexpr bool PERM = true, CHAIN = false; static constexpr int LAST_TAG = 0;
    bf16_t* O; int ldc;
    __device__ __forceinline__ void operator()(const f32x4 (&acc)[2][2][4][2], const Unit& u, int wr, int wc, int fr, int fq) const {
        const int row0 = u.pm * BM + wr * 64 + fr, col0 = u.pn * BM + wc * 32 + 8 * fq;
#pragma unroll
        for (int ai = 0; ai < 2; ++ai)
#pragma unroll
            for (int m = 0; m < 4; ++m) { bf16_t* rowp = O + (size_t)(row0 + ai * HALF + m * 16) * ldc + col0;
#pragma unroll
                for (int bj = 0; bj < 2; ++bj) { const f32x4 v0 = acc[ai][bj][m][0], v1 = acc[ai][bj][m][1];
                    u32x4 w; w.x = cvt_pk_bf16(v0[0], v0[1]); w.y = cvt_pk_bf16(v0[2], v0[3]); w.z = cvt_pk_bf16(v1[0], v1[1]); w.w = cvt_pk_bf16(v1[2], v1[3]);
                    *(u32x4*)(rowp + bj * HALF) = w; } }
    }
};
struct EpiF32 {
    static constexpr bool PERM = false, CHAIN = false; static constexpr int LAST_TAG = 0;
    float* C; int ldc;
    __device__ __forceinline__ void operator()(const f32x4 (&acc)[2][2][4][2], const Unit& u, int wr, int wc, int fr, int fq) const {
        const int row0 = u.pm * BM + wr * 64 + fr, col0 = u.pn * BM + wc * 32 + 4 * fq;
#pragma unroll
        for (int ai = 0; ai < 2; ++ai)
#pragma unroll
            for (int m = 0; m < 4; ++m) { float* rowp = C + (size_t)(row0 + ai * HALF + m * 16) * ldc + col0;
#pragma unroll
                for (int bj = 0; bj < 2; ++bj)
#pragma unroll
                    for (int n = 0; n < 2; ++n) *(f32x4*)(rowp + bj * HALF + n * 16) = acc[ai][bj][m][n]; }
    }
};
struct EpiSmall {
    static constexpr bool PERM = true, CHAIN = false; static constexpr int LAST_TAG = 0;
    bf16_t* O; const bf16_t* P; const float* pool_scale;
    __device__ __forceinline__ void operator()(const f32x4 (&acc)[2][2][4][2], const Unit& u, int wr, int wc, int fr, int fq) const {
        const int row0 = u.pm * BM + wr * 64 + fr, col0 = u.pn * BM + wc * 32 + 8 * fq;
        const int gcol = u.tag ? B_G : D_G, ocol = u.tag ? 512 : 1536;
#pragma unroll
        for (int bj = 0; bj < 2; ++bj) {
            const int c = col0 + bj * HALF;
            f32x4 s0 = (f32x4){1.f, 1.f, 1.f, 1.f}, s1 = s0;
            if (u.tag) { s0 = *(const f32x4*)(pool_scale + c); s1 = *(const f32x4*)(pool_scale + c + 4); }
#pragma unroll
            for (int ai = 0; ai < 2; ++ai)
#pragma unroll
                for (int m = 0; m < 4; ++m) {
                    const size_t row = (size_t)(row0 + ai * HALF + m * 16);
                    const u32x4 gw = *(const u32x4*)(P + row * INC + gcol + c);
                    const f32x4 v0 = acc[ai][bj][m][0] * s0, v1 = acc[ai][bj][m][1] * s1;
                    u32x4 w;
                    w.x = cvt_pk_bf16(v0[0] * siluf_(lo_bf(gw.x)), v0[1] * siluf_(hi_bf(gw.x)));
                    w.y = cvt_pk_bf16(v0[2] * siluf_(lo_bf(gw.y)), v0[3] * siluf_(hi_bf(gw.y)));
                    w.z = cvt_pk_bf16(v1[0] * siluf_(lo_bf(gw.z)), v1[1] * siluf_(hi_bf(gw.z)));
                    w.w = cvt_pk_bf16(v1[2] * siluf_(lo_bf(gw.w)), v1[3] * siluf_(hi_bf(gw.w)));
                    *(u32x4*)(O + row * DM + ocol + c) = w;
                }
        }
    }
};
struct EpiMerge {
    static constexpr bool PERM = true, CHAIN = true; static constexpr int LAST_TAG = 3;
    bf16_t* Y1; const bf16_t* P;
    __device__ __forceinline__ void operator()(f32x4 (&acc)[2][2][4][2], const Unit& u, int wr, int wc, int fr, int fq) const {
        const int row0 = u.pm * BM + wr * 64 + fr, col0 = u.pn * BM + wc * 32 + 8 * fq;
        const int b = u.tag;
#pragma unroll
        for (int ai = 0; ai < 2; ++ai)
#pragma unroll
            for (int m = 0; m < 4; ++m) {
                const size_t row = (size_t)(row0 + ai * HALF + m * 16);
#pragma unroll
                for (int bj = 0; bj < 2; ++bj) {
                    const int c = col0 + bj * HALF;
                    const u32x4 gw = *(const u32x4*)(P + row * INC + MERGE + b * DM + c);
                    float eb[8] = {fexp2(-lo_bf(gw.x) * LOG2E), fexp2(-hi_bf(gw.x) * LOG2E), fexp2(-lo_bf(gw.y) * LOG2E), fexp2(-hi_bf(gw.y) * LOG2E),
                                   fexp2(-lo_bf(gw.z) * LOG2E), fexp2(-hi_bf(gw.z) * LOG2E), fexp2(-lo_bf(gw.w) * LOG2E), fexp2(-hi_bf(gw.w) * LOG2E)};
                    f32x4 v0 = acc[ai][bj][m][0], v1 = acc[ai][bj][m][1];
                    if (b != 3) {
                        const u32x4 gn = *(const u32x4*)(P + row * INC + MERGE + (b + 1) * DM + c);
                        float en[8] = {fexp2(-lo_bf(gn.x) * LOG2E), fexp2(-hi_bf(gn.x) * LOG2E), fexp2(-lo_bf(gn.y) * LOG2E), fexp2(-hi_bf(gn.y) * LOG2E),
                                       fexp2(-lo_bf(gn.z) * LOG2E), fexp2(-hi_bf(gn.z) * LOG2E), fexp2(-lo_bf(gn.w) * LOG2E), fexp2(-hi_bf(gn.w) * LOG2E)};
#pragma unroll
                        for (int e = 0; e < 4; ++e) { v0[e] *= (1.0f + en[e]) * __builtin_amdgcn_rcpf(1.0f + eb[e]); v1[e] *= (1.0f + en[4 + e]) * __builtin_amdgcn_rcpf(1.0f + eb[4 + e]); }
                        acc[ai][bj][m][0] = v0; acc[ai][bj][m][1] = v1;
                    } else {
#pragma unroll
                        for (int e = 0; e < 4; ++e) { v0[e] *= __builtin_amdgcn_rcpf(1.0f + eb[e]); v1[e] *= __builtin_amdgcn_rcpf(1.0f + eb[4 + e]); }
                        u32x4 w; w.x = cvt_pk_bf16(v0[0], v0[1]); w.y = cvt_pk_bf16(v0[2], v0[3]); w.z = cvt_pk_bf16(v1[0], v1[1]); w.w = cvt_pk_bf16(v1[2], v1[3]);
                        *(u32x4*)(Y1 + row * DM + c) = w;
                    }
                }
            }
    }
};
}

template <int NB>
__device__ __forceinline__ void transpose_load(f32x4 (&v)[2 * NB], const float* src, int sp, int tid) {
#pragma unroll
    for (int i = 0; i < 2 * NB; ++i) { const int idx = tid + i * 512, r = idx / (16 * NB), cc = idx % (16 * NB);
        v[i] = *(const f32x4*)(src + (size_t)r * sp + cc * 4); }
}
template <int NB>
__device__ __forceinline__ void transpose_store(LAS float* tile, const f32x4 (&v)[2 * NB], bf16_t* dst, int dp, int tid) {
#pragma unroll
    for (int i = 0; i < 2 * NB; ++i) { const int idx = tid + i * 512, r = idx / (16 * NB), cc = idx % (16 * NB), j = cc >> 4, c4 = cc & 15;
        LAS float* t = tile + j * (64 * 65) + r * 65 + c4 * 4; t[0] = v[i][0]; t[1] = v[i][1]; t[2] = v[i][2]; t[3] = v[i][3]; }
    __syncthreads();
    { const int c = tid >> 3, r8 = (tid & 7) * 8;
#pragma unroll
      for (int j = 0; j < NB; ++j) { float w8[8];
#pragma unroll
          for (int e = 0; e < 8; ++e) w8[e] = tile[j * (64 * 65) + (r8 + e) * 65 + c];
          u32x4 w; w.x = cvt_pk_bf16(w8[0], w8[1]); w.y = cvt_pk_bf16(w8[2], w8[3]); w.z = cvt_pk_bf16(w8[4], w8[5]); w.w = cvt_pk_bf16(w8[6], w8[7]);
          *(u32x4*)(dst + (size_t)(j * 64 + c) * dp + r8) = w; } }
    __syncthreads();
}
template <int NB>
__device__ __forceinline__ void transpose_batch(LAS float* tile, const float* src, int sp, bf16_t* dst, int dp, int tid) {
    f32x4 v[2 * NB]; transpose_load<NB>(v, src, sp, tid); transpose_store<NB>(tile, v, dst, dp, tid);
}

__device__ void phase0(const Params& p, LAS unsigned char* lds, int bid, int nb) {
    const int tid = opaque_tid();
    bf16_t* WIN = (bf16_t*)(p.ws + WS_WIN); bf16_t* WBR = (bf16_t*)(p.ws + WS_WBR); bf16_t* WOUT = (bf16_t*)(p.ws + WS_WOUT);
    bf16_t* WPW = (bf16_t*)(p.ws + WS_WPW); bf16_t* WPOOL = (bf16_t*)(p.ws + WS_WPOOL);
    float* MOD = (float*)(p.ws + WS_MOD); float* ROPE = (float*)(p.ws + WS_ROPE);
    for (int task = bid; task < 384; task += nb) {
        const int l = task / 96, j0 = (task % 96) * 64;
        LAS float* sv = (LAS float*)lds;
        LAS float* red = sv + 4096;
        for (int k = tid; k < 2048; k += 512) { sv[k] = siluf_(p.c[k]); sv[2048 + k] = siluf_(p.c_ctx[k]); }
        __syncthreads();
        const int kg = tid >> 4, q = tid & 15;
        const float* w = p.w_ada + (size_t)l * 2048 * 6144 + (size_t)(kg * 64) * 6144 + j0 + q * 4;
        f32x4 a0 = {0.f, 0.f, 0.f, 0.f}, a1 = a0;
#pragma unroll 16
        for (int k = 0; k < 64; ++k) { const f32x4 wv = *(const f32x4*)(w + (size_t)k * 6144); a0 += wv * sv[kg * 64 + k]; a1 += wv * sv[2048 + kg * 64 + k]; }
#pragma unroll
        for (int e = 0; e < 4; ++e) { red[(kg * 64 + q * 4 + e) * 2 + 0] = a0[e]; red[(kg * 64 + q * 4 + e) * 2 + 1] = a1[e]; }
        __syncthreads();
        if (tid < 128) { const int v = tid >> 6, j = tid & 63; float sum = 0.f;
#pragma unroll
            for (int g = 0; g < 32; ++g) sum += red[(g * 64 + j) * 2 + v];
            MOD[((size_t)l * 2 + v) * 6144 + j0 + j] = sum + p.b_ada[l * 6144 + j0 + j]; }
        __syncthreads();
    }
    if (bid == nb - 1) {
        for (int i = tid; i < 2048; i += 512) { const int pos = i >> 4, j = i & 15;
            const float f = exp2f(-(float)j * (13.287712379549449f / 16.0f)); const float ang = (float)pos * f;
            ROPE[i] = cosf(ang); ROPE[2048 + i] = sinf(ang); }
    }
    for (int i = bid * 512 + tid; i < DEPTH * 512 * 512; i += nb * 512) { const int rr = (i >> 9) & 511, cc = i & 511; if ((rr >> 7) != (cc >> 7)) WPOOL[i] = 0; }
    LAS float* tile = (LAS float*)lds;
    {
        auto decode = [&](int b, const float*& src, bf16_t*& dst, int& sp, int& dp) {
            if (b < 7040) { const int l = b / 1760, bb = b % 1760, rt = bb / 55, ct = (bb % 55) * 4;
                src = p.w_in + (size_t)l * DM * INC + (size_t)(rt * 64) * INC + ct * 64; sp = INC; dst = WIN + (size_t)l * INC * DM + (size_t)(ct * 64) * DM + rt * 64; dp = DM; }
            else if (b < 8064) { const int tt = b - 7040, lb = tt >> 6, r = tt & 63, rt = r >> 3, ct = (r & 7) * 4;
                src = p.w_branch + (size_t)lb * 512 * DM + (size_t)(rt * 64) * DM + ct * 64; sp = DM; dst = WBR + (size_t)(lb >> 2) * DM * DM + (size_t)(ct * 64) * DM + (lb & 3) * 512 + rt * 64; dp = DM; }
            else if (b < 9088) { const int tt = b - 8064, l = tt >> 8, r = tt & 255, rt = r >> 3, ct = (r & 7) * 4;
                src = p.w_out + (size_t)l * DM * DM + (size_t)(rt * 64) * DM + ct * 64; sp = DM; dst = WOUT + (size_t)l * DM * DM + (size_t)(ct * 64) * DM + rt * 64; dp = DM; }
            else { const int tt = b - 9088, l = tt >> 4, r = tt & 15, rt = r >> 1, ct = (r & 1) * 4;
                src = p.conv_pw + (size_t)l * 512 * 512 + (size_t)(rt * 64) * 512 + ct * 64; sp = 512; dst = WPW + (size_t)l * 512 * 512 + (size_t)(ct * 64) * 512 + rt * 64; dp = 512; }
        };
        const float* src; bf16_t* dst; int sp, dp; f32x4 v[8], vn[8];
        if (bid < 9152) { decode(bid, src, dst, sp, dp); transpose_load<4>(v, src, sp, tid); }
        for (int b = bid; b < 9152; b += nb) {
            const int bn = b + nb; const bool hn = bn < 9152;
            const float* srcn = src; bf16_t* dstn = dst; int spn = sp, dpn = dp;
            if (hn) { decode(bn, srcn, dstn, spn, dpn); transpose_load<4>(vn, srcn, spn, tid); }
            transpose_store<4>(tile, v, dst, dp, tid);
            if (hn) {
#pragma unroll
                for (int i = 0; i < 8; ++i) v[i] = vn[i];
                dst = dstn; dp = dpn; src = srcn; sp = spn; }
        }
    }
    for (int tt = bid; tt < 64; tt += nb) { const int lg = tt >> 2, r = tt & 3, rt = r >> 1, ct = r & 1, l = lg >> 2, gi = lg & 3;
        transpose_batch<1>(tile, p.pool_w + (size_t)lg * 128 * 128 + (size_t)(rt * 64) * 128 + ct * 64, 128,
                           WPOOL + (size_t)l * 512 * 512 + (size_t)(gi * 128 + ct * 64) * 512 + gi * 128 + rt * 64, 512, tid); }
}

__device__ void phase_rows(const Params& p, int l, int bid, int nb) {
    const int tid = opaque_tid(), wid = tid >> 6, lane = tid & 63;
    const float* MOD = (const float*)(p.ws + WS_MOD); const float* Y = (const float*)(p.ws + WS_Y); float* X = (float*)(p.ws + WS_X); bf16_t* H = (bf16_t*)(p.ws + WS_H);
    const int ln = l + 1, nrows = (l == DEPTH - 1) ? SEQ : MT;
    for (int row = bid * 8 + wid; row < nrows; row += nb * 8) {
        const int v = row >= SEQ ? 1 : 0;
        const float* xsrc = (l <= 0) ? (v ? p.ctx + (size_t)(row - SEQ) * DM : p.x + (size_t)row * DM) : X + (size_t)row * DM;
        f32x4 xv[8];
#pragma unroll
        for (int i = 0; i < 8; ++i) xv[i] = *(const f32x4*)(xsrc + (i * 64 + lane) * 4);
        if (l >= 0) {
            f32x4 yv[8]; float ss = 0.f;
#pragma unroll
            for (int i = 0; i < 8; ++i) { yv[i] = *(const f32x4*)(Y + (size_t)row * DM + (i * 64 + lane) * 4); ss += yv[i][0] * yv[i][0] + yv[i][1] * yv[i][1] + yv[i][2] * yv[i][2] + yv[i][3] * yv[i][3]; }
            ss = wave_sum(ss); const float rstd = rsqrtf(ss * (1.0f / DM) + EPS);
            const float* gate = MOD + ((size_t)l * 2 + v) * 6144 + 4096; const float* gp = p.g_post + (size_t)l * DM;
            float* dst = (l == DEPTH - 1) ? p.out + (size_t)row * DM : X + (size_t)row * DM;
#pragma unroll
            for (int i = 0; i < 8; ++i) { const int c = (i * 64 + lane) * 4; const f32x4 g = *(const f32x4*)(gate + c), q = *(const f32x4*)(gp + c);
                xv[i] = xv[i] + g * (yv[i] * rstd * q); *(f32x4*)(dst + c) = xv[i]; }
        }
        if (ln < DEPTH) {
            float ss = 0.f;
#pragma unroll
            for (int i = 0; i < 8; ++i) ss += xv[i][0] * xv[i][0] + xv[i][1] * xv[i][1] + xv[i][2] * xv[i][2] + xv[i][3] * xv[i][3];
            ss = wave_sum(ss); const float rstd = rsqrtf(ss * (1.0f / DM) + EPS);
            const float* md = MOD + ((size_t)ln * 2 + v) * 6144; const float* gpre = p.g_pre + (size_t)ln * DM;
#pragma unroll
            for (int i = 0; i < 8; ++i) { const int c = (i * 64 + lane) * 4; const f32x4 sh = *(const f32x4*)(md + c), sc = *(const f32x4*)(md + 2048 + c), q = *(const f32x4*)(gpre + c);
                const f32x4 hv = xv[i] * rstd * q * (1.0f + sc) + sh;
                u32x2 w; w.x = cvt_pk_bf16(hv[0], hv[1]); w.y = cvt_pk_bf16(hv[2], hv[3]); *(u32x2*)(H + (size_t)row * DM + c) = w; }
        }
    }
}

__device__ void phase_prep(const Params& p, LAS unsigned char* lds, int l, int bid, int nb) {
    const int tid = opaque_tid(), wid = tid >> 6, lane = tid & 63;
    const bf16_t* P = (const bf16_t*)(p.ws + WS_P); bf16_t* QALL = (bf16_t*)(p.ws + WS_QALL); bf16_t* KC = (bf16_t*)(p.ws + WS_KC); bf16_t* VT = (bf16_t*)(p.ws + WS_VT);
    bf16_t* DLN = (bf16_t*)(p.ws + WS_DLN); bf16_t* DP = (bf16_t*)(p.ws + WS_DP); const float* ROPE = (const float*)(p.ws + WS_ROPE);
    const bool lastl = (l == DEPTH - 1);
    LAS float* lu = (LAS float*)lds;
    constexpr int NT32 = MT / 32, NT64 = MT / 64, NUNITS = 3 * NT32 + NT64;
    for (int u = bid; u < NUNITS; u += nb) {
        const int wt = u < 3 * NT32 ? u / NT32 : 3;
        const int tile = u < 3 * NT32 ? u % NT32 : u - 3 * NT32;
        if (wt == 3) {
            const int t0 = tile * 64;
            for (int idx = tid; idx < 160 * 8; idx += 512) {
                const int hd0 = (idx >> 3) * 4, tq = idx & 7, col = hd0 < 512 ? A_V + hd0 : C_V + (hd0 - 512);
                const bf16_t* sp_ = P + (size_t)(t0 + tq * 8) * INC + col; u32x2 w8[8];
#pragma unroll
                for (int j = 0; j < 8; ++j) w8[j] = *(const u32x2*)(sp_ + (size_t)j * INC);
#pragma unroll
                for (int e = 0; e < 4; ++e) { unsigned v[8];
#pragma unroll
                    for (int j = 0; j < 8; ++j) { const unsigned word = (e < 2) ? w8[j].x : w8[j].y; v[j] = (e & 1) ? (word >> 16) : (word & 0xffffu); }
                    u32x4 w; w.x = v[0] | (v[1] << 16); w.y = v[2] | (v[3] << 16); w.z = v[4] | (v[5] << 16); w.w = v[6] | (v[7] << 16);
                    *(u32x4*)(VT + (size_t)(hd0 + e) * MT + t0 + tq * 8) = w; } }
            continue;
        }
        const int t0 = tile * 32; const bool isctx = tile >= SEQ / 32; const bool kvonly = lastl && isctx;
        const int sb = isctx ? SEQ : 0, L = isctx ? NCTX : SEQ;
        if (wt == 2) {
            const float qn = p.q_norm[l * 64 + lane], kn = p.k_norm[l * 64 + lane];
            for (int q4 = 0; q4 < 4; ++q4) {
                const int t = t0 + wid * 4 + q4;
                float cs = 1.f, sn = 0.f;
                if (!isctx) { const int pos = lane < 32 ? (t >> 6) : (t & 63), j = lane & 15; cs = ROPE[pos * 16 + j]; sn = ROPE[2048 + pos * 16 + j]; }
                const bf16_t* prow = P + (size_t)t * INC + lane;
                float xs[18];
#pragma unroll
                for (int hh = 0; hh < 18; ++hh) { const int col = hh < 8 ? A_Q + hh * 64 : (hh < 16 ? C_Q + (hh - 8) * 64 : C_K + (hh - 16) * 64);
                    xs[hh] = (kvonly && hh < 16) ? 0.f : bf2f(prow[col]); }
#pragma unroll
                for (int hh = 0; hh < 18; ++hh) {
                    if (kvonly && hh < 16) continue;
                    if (hh < 8) { QALL[(size_t)t * 1024 + hh * 64 + lane] = f2bf(xs[hh] * QS); }
                    else {
                        const bool isq = hh < 16; const float x = xs[hh];
                        const float ss = wave_sum(x * x); const float rn = rsqrtf(ss * (1.0f / 64.0f) + EPS);
                        float xn = x * rn * (isq ? qn : kn);
                        if (!isctx) { const float pr = __shfl_xor(xn, 16); xn = (lane & 16) ? (xn * cs + pr * sn) : (xn * cs - pr * sn); }
                        if (isq) QALL[(size_t)t * 1024 + hh * 64 + lane] = f2bf(xn * QS); else KC[(size_t)t * 128 + (hh - 16) * 64 + lane] = f2bf(xn);
                    }
                }
            }
            continue;
        }
        if (kvonly) continue;
        if (wt == 1) {
            const int cg4 = tid & 127, tg = tid >> 7, c = cg4 * 4, gi = c >> 7, ksz = 2 << gi;
            const bf16_t* ub = P + (size_t)sb * INC + B_IN + c;
            const int tt0 = t0 - sb + tg * 8;
            int lo = max(tt0 - ksz / 2, 0), hi = min(tt0 + ksz - 1 - ksz / 2, L - 1);
            f32x4 sm = {0.f, 0.f, 0.f, 0.f};
#pragma unroll
            for (int i = 0; i < 16; ++i) { const int idx = lo + i; if (idx <= hi) sm += ld4bf(ub + (size_t)idx * INC); }
#pragma unroll
            for (int tl = 0; tl < 8; ++tl) { const int tt = tt0 + tl;
                const int nlo = max(tt - ksz / 2, 0), nhi = min(tt + ksz - 1 - ksz / 2, L - 1);
                if (nhi > hi) { sm += ld4bf(ub + (size_t)nhi * INC); hi = nhi; }
                if (nlo > lo) { sm -= ld4bf(ub + (size_t)lo * INC); lo = nlo; }
                const f32x4 d = sm * (1.0f / (float)(hi - lo + 1)) - ld4bf(ub + (size_t)tt * INC);
                u32x2 w; w.x = cvt_pk_bf16(d[0], d[1]); w.y = cvt_pk_bf16(d[2], d[3]);
                *(u32x2*)(DP + (size_t)(sb + tt) * 512 + c) = w; }
            continue;
        }
        { const int c = tid;
          { const int c4 = (tid & 127) * 4;
#pragma unroll 8
            for (int rr = tid >> 7; rr < 62; rr += 4) { const int tt = t0 - sb - 15 + rr; f32x4 uv = {0.f, 0.f, 0.f, 0.f};
              if (tt >= 0 && tt < L) { const bf16_t* q = P + (size_t)(sb + tt) * INC + D_GLU + c4; const f32x4 a = ld4bf(q), g = ld4bf(q + 512);
                  uv = (f32x4){a[0] * sigmoidf_(g[0]), a[1] * sigmoidf_(g[1]), a[2] * sigmoidf_(g[2]), a[3] * sigmoidf_(g[3])}; }
              *(LAS f32x4*)(lu + rr * 512 + c4) = uv; } }
          __syncthreads();
          float w[31];
#pragma unroll
          for (int j = 0; j < 31; ++j) w[j] = p.conv_w[((size_t)l * 31 + j) * 512 + c];
          const float cb = p.conv_b[l * 512 + c];
          float y[32];
#pragma unroll
          for (int tl = 0; tl < 32; ++tl) { float a = cb;
#pragma unroll
              for (int j = 0; j < 31; ++j) a += lu[(tl + j) * 512 + c] * w[j];
              y[tl] = a; }
          __syncthreads();
#pragma unroll
          for (int tl = 0; tl < 32; ++tl) lu[tl * 512 + c] = y[tl];
          __syncthreads();
          for (int q = 0; q < 4; ++q) { const int tl = wid * 4 + q; float v[8]; float sm = 0.f;
#pragma unroll
              for (int i = 0; i < 8; ++i) { v[i] = lu[tl * 512 + i * 64 + lane]; sm += v[i]; }
              const float mu = wave_sum(sm) * (1.0f / 512.0f); float qq = 0.f;
#pragma unroll
              for (int i = 0; i < 8; ++i) { const float d = v[i] - mu; qq += d * d; }
              const float rstd = rsqrtf(wave_sum(qq) * (1.0f / 512.0f) + EPS);
#pragma unroll
              for (int i = 0; i < 8; ++i) { const int cc = i * 64 + lane; const float z = (v[i] - mu) * rstd * p.conv_ln_g[l * 512 + cc] + p.conv_ln_b[l * 512 + cc];
                  DLN[(size_t)(t0 + tl) * 512 + cc] = f2bf(siluf_(z)); } }
          __syncthreads(); }
    }
}

struct AttnUnit {
    const bf16_t* kbase; int kpitch;
    int qhead, tok0, ntiles, vth, gcol, ocol;
    int nband, nbp, rlo, kctx0;
    int rq, c0, rs, bh;
};
template <bool MASK>
__device__ __forceinline__ void attn_core(LAS unsigned char* lds, const Params& p, int l, const AttnUnit& a) {
    const int tid = opaque_tid(), lane = tid & 63, r = lane & 31, h2 = lane >> 5;
    const bf16_t* P = (const bf16_t*)(p.ws + WS_P); const bf16_t* QALL = (const bf16_t*)(p.ws + WS_QALL); const bf16_t* VT = (const bf16_t*)(p.ws + WS_VT); bf16_t* O = (bf16_t*)(p.ws + WS_O);
    LAS float* tab = (LAS float*)(lds + 65536);
    if (MASK) { for (int i = tid; i < 465; i += 512) tab[i] = p.na_rpb[((size_t)l * 8 + a.bh) * 465 + i] * LOG2E; }
    bf16x8 qf[4];
    { const bf16_t* qp = QALL + (size_t)(a.tok0 + r) * 1024 + a.qhead * 64 + 8 * h2;
#pragma unroll
      for (int ks = 0; ks < 4; ++ks) qf[ks] = *(const bf16x8*)(qp + 16 * ks); }
    const int lrow = tid >> 3, lch = tid & 7;
    const unsigned st_off = (unsigned)(lrow * 128 + ((lch ^ ((lrow >> 1) & 7)) << 4));
    const bf16_t* vrow = VT + ((size_t)a.vth * 64 + lrow) * MT + lch * 8;
    const bf16_t* krow = a.kbase + (size_t)lrow * a.kpitch + lch * 8;
#define KEY0(j) ((j) < a.nband ? (a.rlo + (j)) * 64 : ((j) < a.nbp ? a.rlo * 64 : a.kctx0 + ((j) - a.nbp) * 64))
    const int pr = (r & 19) | ((r & 4) << 1) | ((r & 8) >> 1);
    const unsigned ksw = (unsigned)((pr >> 1) & 7), vsw = (unsigned)((r >> 1) & 7);
    f32x16 o0, o1;
#pragma unroll
    for (int i = 0; i < 16; ++i) { o0[i] = 0.f; o1[i] = 0.f; }
    float m_run = 0.f, l_run = 0.f; bool started = false;
    const int nbig = a.ntiles >> 1;
    u32x4 kr[2], vr[2];
#define LOADB(J) { _Pragma("unroll") for (int u_ = 0; u_ < 2; ++u_) { const int k0_ = KEY0(2 * (J) + u_); kr[u_] = *(const u32x4*)(krow + (size_t)k0_ * a.kpitch); vr[u_] = *(const u32x4*)(vrow + k0_); } }
#define STOREB(slot) { LAS unsigned char* sb_ = lds + (slot) * 32768; _Pragma("unroll") for (int u_ = 0; u_ < 2; ++u_) { *(LAS u32x4*)(sb_ + u_ * 16384 + st_off) = kr[u_]; *(LAS u32x4*)(sb_ + u_ * 16384 + 8192 + st_off) = vr[u_]; } }
    LOADB(0); STOREB(0);
    __syncthreads();
    for (int J = 0; J < nbig; ++J) {
        const bool more = (J + 1 < nbig);
        if (more) LOADB(J + 1);
#pragma unroll
        for (int u = 0; u < 2; ++u) {
        const int j = 2 * J + u;
        bool active = true; int brow = 0;
        if (MASK) { if (j < a.nband) { const int kr_ = a.rlo + j; active = (kr_ >= a.rs) && (kr_ <= a.rs + 7); brow = kr_ - a.rq + 7; } else if (j < a.nbp) active = false; }
        if (active) {
            LAS unsigned char* Kb = lds + (J & 1) * 32768 + u * 16384; LAS unsigned char* Vb = Kb + 8192;
            bf16x8 kf[8];
#pragma unroll
            for (int ks = 0; ks < 4; ++ks) { const unsigned ch = (unsigned)(2 * ks + h2);
                kf[2 * ks] = *(const LAS bf16x8*)(Kb + pr * 128 + ((ch ^ ksw) << 4));
                kf[2 * ks + 1] = *(const LAS bf16x8*)(Kb + 4096 + pr * 128 + ((ch ^ ksw) << 4)); }
            const float negm = -m_run;
            f32x16 s0, s1;
#pragma unroll
            for (int i = 0; i < 16; ++i) { s0[i] = negm; s1[i] = negm; }
#pragma unroll
            for (int ks = 0; ks < 4; ++ks) {
                s0 = __builtin_amdgcn_mfma_f32_32x32x16_bf16(kf[2 * ks], qf[ks], s0, 0, 0, 0);
                s1 = __builtin_amdgcn_mfma_f32_32x32x16_bf16(kf[2 * ks + 1], qf[ks], s1, 0, 0, 0); }
            bf16x8 vf[8];
#pragma unroll
            for (int kt = 0; kt < 2; ++kt)
#pragma unroll
                for (int sx = 0; sx < 2; ++sx) { const unsigned ch = (unsigned)(4 * kt + 2 * sx + h2);
                    vf[(kt * 2 + sx) * 2] = *(const LAS bf16x8*)(Vb + r * 128 + ((ch ^ vsw) << 4));
                    vf[(kt * 2 + sx) * 2 + 1] = *(const LAS bf16x8*)(Vb + 4096 + r * 128 + ((ch ^ vsw) << 4)); }
            if (MASK) { if (j < a.nband) {
                const int cq = a.c0 + r, cs = clampi(cq - 8, 0, 48);
#pragma unroll
                for (int i = 0; i < 16; ++i) {
                    const int kc0 = 16 * (i >> 3) + 8 * h2 + 4 * ((i >> 2) & 1) + (i & 3), kc1 = kc0 + 32;
                    const bool v0 = (kc0 >= cs) && (kc0 < cs + 16), v1 = (kc1 >= cs) && (kc1 < cs + 16);
                    const float b0 = tab[brow * 31 + clampi(kc0 - cq + 15, 0, 30)], b1 = tab[brow * 31 + clampi(kc1 - cq + 15, 0, 30)];
                    s0[i] = v0 ? s0[i] + b0 : -1e30f; s1[i] = v1 ? s1[i] + b1 : -1e30f; } } }
            float mx = fmaxf(s0[0], s1[0]);
#pragma unroll
            for (int i = 1; i < 16; ++i) mx = fmaxf(fmaxf(mx, s0[i]), s1[i]);
            mx = fmaxf(mx, __shfl_xor(mx, 32));
            const bool slow = !started || (__builtin_amdgcn_ballot_w64(mx > 8.0f) != 0ull);
            if (slow) {
                const float delta = started ? fmaxf(mx, 0.f) : mx;
                const float alpha = fexp2(-delta);
#pragma unroll
                for (int i = 0; i < 16; ++i) { s0[i] -= delta; s1[i] -= delta; o0[i] *= alpha; o1[i] *= alpha; }
                l_run *= alpha; m_run += delta;
            }
            started = true;
            typedef float f32x2_ __attribute__((ext_vector_type(2)));
            f32x2_ acc2 = {0.f, 0.f};
#pragma unroll
            for (int i = 0; i < 16; ++i) { s0[i] = fexp2(s0[i]); s1[i] = fexp2(s1[i]); }
#pragma unroll
            for (int i = 0; i < 8; ++i) { acc2 += (f32x2_){s0[2 * i], s0[2 * i + 1]}; acc2 += (f32x2_){s1[2 * i], s1[2 * i + 1]}; }
            l_run += acc2.x + acc2.y;
            bf16x8 pb[2][2];
#pragma unroll
            for (int sx = 0; sx < 2; ++sx) {
                u32x4 w0, w1;
                w0.x = cvt_pk_bf16(s0[8 * sx + 0], s0[8 * sx + 1]); w0.y = cvt_pk_bf16(s0[8 * sx + 2], s0[8 * sx + 3]); w0.z = cvt_pk_bf16(s0[8 * sx + 4], s0[8 * sx + 5]); w0.w = cvt_pk_bf16(s0[8 * sx + 6], s0[8 * sx + 7]);
                w1.x = cvt_pk_bf16(s1[8 * sx + 0], s1[8 * sx + 1]); w1.y = cvt_pk_bf16(s1[8 * sx + 2], s1[8 * sx + 3]); w1.z = cvt_pk_bf16(s1[8 * sx + 4], s1[8 * sx + 5]); w1.w = cvt_pk_bf16(s1[8 * sx + 6], s1[8 * sx + 7]);
                pb[0][sx] = __builtin_bit_cast(bf16x8, w0); pb[1][sx] = __builtin_bit_cast(bf16x8, w1); }
#pragma unroll
            for (int kt = 0; kt < 2; ++kt)
#pragma unroll
                for (int sx = 0; sx < 2; ++sx) {
                    o0 = __builtin_amdgcn_mfma_f32_32x32x16_bf16(vf[(kt * 2 + sx) * 2], pb[kt][sx], o0, 0, 0, 0);
                    o1 = __builtin_amdgcn_mfma_f32_32x32x16_bf16(vf[(kt * 2 + sx) * 2 + 1], pb[kt][sx], o1, 0, 0, 0); }
        }
        }
        if (more) STOREB((J + 1) & 1);
        __syncthreads();
    }
#undef KEY0
#undef LOADB
#undef STOREB
    { const float lt = l_run + __shfl_xor(l_run, 32); const float inv = 1.0f / lt; const size_t tok = (size_t)(a.tok0 + r);
#pragma unroll
      for (int dt = 0; dt < 2; ++dt)
#pragma unroll
          for (int g4 = 0; g4 < 4; ++g4) { const int dim = dt * 32 + 8 * g4 + 4 * h2;
              const u32x2 gw = *(const u32x2*)(P + tok * INC + a.gcol + dim);
              const float e0 = (dt ? o1[4 * g4 + 0] : o0[4 * g4 + 0]) * inv * siluf_(lo_bf(gw.x)), e1 = (dt ? o1[4 * g4 + 1] : o0[4 * g4 + 1]) * inv * siluf_(hi_bf(gw.x));
              const float e2 = (dt ? o1[4 * g4 + 2] : o0[4 * g4 + 2]) * inv * siluf_(lo_bf(gw.y)), e3 = (dt ? o1[4 * g4 + 3] : o0[4 * g4 + 3]) * inv * siluf_(hi_bf(gw.y));
              u32x2 w; w.x = cvt_pk_bf16(e0, e1); w.y = cvt_pk_bf16(e2, e3);
              *(u32x2*)(O + tok * DM + a.ocol + dim) = w; } }
}

__device__ void phase_mix(const Params& p, LAS unsigned char* lds, int l, int bid, int nb) {
    const int wid = __builtin_amdgcn_readfirstlane(opaque_tid() >> 6);
    const bf16_t* P = (const bf16_t*)(p.ws + WS_P); const bf16_t* KC = (const bf16_t*)(p.ws + WS_KC);
    const int nunits = (l == DEPTH - 1) ? 512 : 528;
    const bool remap = (nb == 256) && (l != DEPTH - 1);
    const int nrounds = remap ? 4 : (nunits + nb - 1) / nb;
    for (int k = 0; k < nrounds; ++k) {
        int u = bid + k * nb;
        if (remap) {
            if (k == 0) u = bid;
            else if (k == 1) u = (bid >= 148 && bid < 171) ? -1 : 256 + bid;
            else if (k == 2) u = (bid >= 171 && bid < 194) ? 256 + bid - 23 : -1;
            else u = bid < 16 ? 512 + bid : -1;
        }
        if (u < 0 || u >= nunits) continue;
        AttnUnit a;
        if (u < 256 || (u >= 512 && u < 520)) {
            const bool cx = u >= 512; const int uu = cx ? u - 512 : u; const int kvh = uu & 1, tb = uu >> 1, hq = kvh * 4 + (wid & 3);
            a.kbase = KC + kvh * 64; a.kpitch = 128; a.qhead = 8 + hq; a.tok0 = (cx ? SEQ : 0) + tb * 64 + (wid >> 2) * 32; a.ntiles = cx ? 4 : 132; a.vth = 8 + kvh;
            a.gcol = C_G + hq * 64; a.ocol = 1024 + hq * 64; a.nband = 0; a.nbp = 0; a.rlo = 0; a.kctx0 = cx ? SEQ : 0; a.rq = 0; a.c0 = 0; a.rs = 0; a.bh = 0;
            attn_core<false>(lds, p, l, a);
        } else if (u >= 520) {
            const int h = u - 520;
            a.kbase = P + A_K + h * 64; a.kpitch = INC; a.qhead = h; a.tok0 = SEQ + wid * 32; a.ntiles = 4; a.vth = h; a.gcol = A_G + h * 64; a.ocol = h * 64;
            a.nband = 0; a.nbp = 0; a.rlo = 0; a.kctx0 = SEQ; a.rq = 0; a.c0 = 0; a.rs = 0; a.bh = 0;
            attn_core<false>(lds, p, l, a);
        } else {
            const int uu = u - 256, h = uu & 7, rg = uu >> 3, rq0 = rg * 4;
            a.kbase = P + A_K + h * 64; a.kpitch = INC; a.qhead = h; a.rq = rq0 + (wid >> 1); a.c0 = (wid & 1) * 32; a.tok0 = a.rq * 64 + a.c0; a.vth = h; a.gcol = A_G + h * 64; a.ocol = h * 64;
            a.rlo = clampi(rq0 - 4, 0, 120); const int rhi = clampi(rq0 + 3 - 4, 0, 120) + 7; a.nband = rhi - a.rlo + 1; a.nbp = (a.nband + 1) & ~1; a.ntiles = a.nbp + 4; a.kctx0 = SEQ; a.rs = clampi(a.rq - 4, 0, 120); a.bh = h;
            attn_core<true>(lds, p, l, a);
        }
    }
    __syncthreads();
    { pg8::Gemm g{(const bf16_t*)(p.ws + WS_DLN), (const bf16_t*)(p.ws + WS_WPW) + (size_t)l * 512 * 512, 512, 512, 512, (size_t)MT * 512, (size_t)DEPTH * 512 * 512};
      pg8::SmallOrder S{nb, (bid + nb - (nunits % nb)) % nb};
      pg8::EpiSmall E{(bf16_t*)(p.ws + WS_O), P, p.pool_scale + (size_t)l * 512};
      pg8::gemm_phase<pg8::EpiSmall, pg8::SmallOrder>(lds, g, S, E); }
    if (l != DEPTH - 1) {
      pg8::Gemm g{(const bf16_t*)(p.ws + WS_H), (const bf16_t*)(p.ws + WS_WIN) + (size_t)l * INC * DM, DM, DM, DM, 0, 0};
      pg8::CtxColsOrder S{nb, (bid + nb - 148) % nb};
      pg8::EpiStoreBf16 E{(bf16_t*)(p.ws + WS_P), INC};
      pg8::gemm_phase<pg8::EpiStoreBf16, pg8::CtxColsOrder>(lds, g, S, E); }
}

__device__ __forceinline__ unsigned xcc_id() { return (unsigned)__builtin_amdgcn_s_getreg((3 << 11) | 20) & 0xFu; }
__device__ __forceinline__ void grid_bar(unsigned* ctl, unsigned& epoch, unsigned x, unsigned nloc, unsigned nx) {
    asm volatile("s_waitcnt vmcnt(0) lgkmcnt(0)" ::: "memory");
    __syncthreads();
    epoch += 1;
    if (threadIdx.x == 0) {
        const unsigned old = __hip_atomic_fetch_add(ctl + 96 + 32 * x, 1u, __ATOMIC_RELAXED, __HIP_MEMORY_SCOPE_AGENT);
        if (old + 1u == epoch * nloc) {
            __builtin_amdgcn_fence(__ATOMIC_RELEASE, "");
            asm volatile("s_waitcnt vmcnt(0)" ::: "memory");
            const unsigned old2 = __hip_atomic_fetch_add(ctl + 64, 1u, __ATOMIC_RELAXED, __HIP_MEMORY_SCOPE_AGENT);
            if (old2 + 1u == epoch * nx) __hip_atomic_store(ctl + 32, epoch, __ATOMIC_RELAXED, __HIP_MEMORY_SCOPE_AGENT);
        }
        while (__hip_atomic_load(ctl + 32, __ATOMIC_RELAXED, __HIP_MEMORY_SCOPE_AGENT) < epoch) __builtin_amdgcn_s_sleep(2);
        __builtin_amdgcn_fence(__ATOMIC_ACQUIRE, "");
        asm volatile("s_waitcnt vmcnt(0) lgkmcnt(0)" ::: "memory");
    }
    __syncthreads();
}
#define GSYNC() grid_bar(gctr, epoch, xcc, nloc, nxcc)

template <bool MRG>
__device__ __forceinline__ void ctx_tail(LAS unsigned char* lds, const Params& p, int l, int bid, int nb) {
    const int tid = opaque_tid(), wid = tid >> 6, lane = tid & 63, r = lane & 31, h = lane >> 5;
    LAS float* part = (LAS float*)lds;
    const bf16_t* P = (const bf16_t*)(p.ws + WS_P);
    const bf16_t* Asrc = MRG ? (const bf16_t*)(p.ws + WS_O) : (const bf16_t*)(p.ws + WS_Y1);
    const bf16_t* Bsrc = (MRG ? (const bf16_t*)(p.ws + WS_WBR) : (const bf16_t*)(p.ws + WS_WOUT)) + (size_t)l * DM * DM;
    constexpr int NTAG = MRG ? 4 : 1, KQ = MRG ? 128 : 512;
    for (int blk = bid; blk < 256; blk += nb) {
        const int rg = blk & 3, cg = blk >> 2, rh = wid & 1, kq = wid >> 1;
        const int row0 = SEQ + rg * 64 + rh * 32, col0 = cg * 32;
        const bf16_t* A = Asrc + (size_t)(row0 + r) * DM + 8 * h;
        const bf16_t* B = Bsrc + (size_t)(col0 + r) * DM + 8 * h;
        f32x16 tot;
#pragma unroll
        for (int i = 0; i < 16; ++i) tot[i] = 0.f;
#pragma unroll 1
        for (int b = 0; b < NTAG; ++b) {
            f32x16 acc;
#pragma unroll
            for (int i = 0; i < 16; ++i) acc[i] = 0.f;
            const int kbase = MRG ? b * 512 + kq * 128 : kq * 512;
#pragma unroll 8
            for (int ks = 0; ks < KQ / 16; ++ks) {
                const bf16x8 af = *(const bf16x8*)(A + kbase + ks * 16);
                const bf16x8 bf = *(const bf16x8*)(B + kbase + ks * 16);
                acc = __builtin_amdgcn_mfma_f32_32x32x16_bf16(bf, af, acc, 0, 0, 0);
            }
            if (MRG) {
#pragma unroll
                for (int g4 = 0; g4 < 4; ++g4) { const int c = col0 + 8 * g4 + 4 * h;
                    const u32x2 gw = *(const u32x2*)(P + (size_t)(row0 + r) * INC + MERGE + b * DM + c);
                    tot[4 * g4 + 0] += acc[4 * g4 + 0] * sigmoidf_(lo_bf(gw.x)); tot[4 * g4 + 1] += acc[4 * g4 + 1] * sigmoidf_(hi_bf(gw.x));
                    tot[4 * g4 + 2] += acc[4 * g4 + 2] * sigmoidf_(lo_bf(gw.y)); tot[4 * g4 + 3] += acc[4 * g4 + 3] * sigmoidf_(hi_bf(gw.y)); }
            } else tot = acc;
        }
#pragma unroll
        for (int i = 0; i < 16; ++i) part[((kq * 2 + rh) * 16 + i) * 64 + lane] = tot[i];
        __syncthreads();
        float v[4];
#pragma unroll
        for (int e = 0; e < 4; ++e) { float a = 0.f;
#pragma unroll
            for (int q = 0; q < 4; ++q) a += part[((q * 2 + rh) * 16 + 4 * kq + e) * 64 + lane];
            v[e] = a; }
        const size_t row = (size_t)(row0 + r); const int c = col0 + 8 * kq + 4 * h;
        if (MRG) { u32x2 w; w.x = cvt_pk_bf16(v[0], v[1]); w.y = cvt_pk_bf16(v[2], v[3]); *(u32x2*)((bf16_t*)(p.ws + WS_Y1) + row * DM + c) = w; }
        else *(f32x4*)((float*)(p.ws + WS_Y) + row * DM + c) = (f32x4){v[0], v[1], v[2], v[3]};
        __syncthreads();
    }
}

__device__ __forceinline__ void run_phase(const Params& p, LAS unsigned char* lds, int ph, int bid0, int nb0) {
    const int bid = opaque_s(bid0), nb = opaque_s(nb0);
    if (ph == 0) { phase0(p, lds, bid, nb); return; }
    if (ph == 1) { phase_rows(p, -1, bid, nb); return; }
    const int l = opaque_s((ph - 2) / 6), q = (ph - 2) % 6;
    if (q == 0) {
        pg8::Gemm g{(const bf16_t*)(p.ws + WS_H), (const bf16_t*)(p.ws + WS_WIN) + (size_t)l * INC * DM, DM, DM, DM, 0, 0};
        pg8::StaticOrder S; S.init(SEQ, INC, nb, bid, l == DEPTH - 1 ? 5 : 32);
        pg8::EpiStoreBf16 E{(bf16_t*)(p.ws + WS_P), INC};
        pg8::gemm_phase<pg8::EpiStoreBf16, pg8::StaticOrder>(lds, g, S, E);
    } else if (q == 1) phase_prep(p, lds, l, bid, nb);
    else if (q == 2) phase_mix(p, lds, l, bid, nb);
    else if (q == 3) {
        pg8::Gemm g{(const bf16_t*)(p.ws + WS_O), (const bf16_t*)(p.ws + WS_WBR) + (size_t)l * DM * DM, DM, DM, 512, 512, 512};
        pg8::TagOrder<4> S; S.init(SEQ, DM, nb, bid);
        pg8::EpiMerge E{(bf16_t*)(p.ws + WS_Y1), (const bf16_t*)(p.ws + WS_P)};
        pg8::gemm_phase<pg8::EpiMerge, pg8::TagOrder<4>>(lds, g, S, E);
        if (l != DEPTH - 1) ctx_tail<true>(lds, p, l, bid, nb);
    } else if (q == 4) {
        pg8::Gemm g{(const bf16_t*)(p.ws + WS_Y1), (const bf16_t*)(p.ws + WS_WOUT) + (size_t)l * DM * DM, DM, DM, DM, 0, 0};
        pg8::StaticOrder S; S.init(SEQ, DM, nb, bid);
        pg8::EpiF32 E{(float*)(p.ws + WS_Y), DM};
        pg8::gemm_phase<pg8::EpiF32, pg8::StaticOrder>(lds, g, S, E);
        if (l != DEPTH - 1) ctx_tail<false>(lds, p, l, bid, nb);
    } else phase_rows(p, l, bid, nb);
}
constexpr int NPHASES = 2 + 6 * DEPTH;
#ifndef N_LAUNCH_MODE
#define N_LAUNCH_MODE 1
#endif
__global__ void __launch_bounds__(512) mega_fwd(Params p, int ph_lo, int ph_hi) {
    extern __shared__ __attribute__((aligned(16))) unsigned char shm_raw[];
    LAS unsigned char* lds = (LAS unsigned char*)shm_raw;
    const int bid = blockIdx.x, nb = gridDim.x;
    unsigned* gctr = (unsigned*)(p.ws + WS_CTL); unsigned epoch = 0;
    const unsigned xcc = (unsigned)__builtin_amdgcn_readfirstlane((int)xcc_id());
    unsigned nloc = 1, nxcc = 1;
    if (N_LAUNCH_MODE == 1) {
        if (threadIdx.x == 0) __hip_atomic_fetch_add(gctr + xcc, 1u, __ATOMIC_RELAXED, __HIP_MEMORY_SCOPE_AGENT);
        cg::grid_group grid = cg::this_grid(); grid.sync();
        nloc = __hip_atomic_load(gctr + xcc, __ATOMIC_RELAXED, __HIP_MEMORY_SCOPE_AGENT); nxcc = 0;
#pragma unroll
        for (int j = 0; j < 16; ++j) nxcc += (__hip_atomic_load(gctr + j, __ATOMIC_RELAXED, __HIP_MEMORY_SCOPE_AGENT) != 0u) ? 1u : 0u;
        nloc = (unsigned)__builtin_amdgcn_readfirstlane((int)nloc); nxcc = (unsigned)__builtin_amdgcn_readfirstlane((int)nxcc);
    }
    for (int ph0 = ph_lo; ph0 < ph_hi; ++ph0) {
        const int ph = opaque_s(ph0);
        run_phase(p, lds, ph, bid, nb);
        if (ph0 + 1 < ph_hi) GSYNC();
    }
}

extern "C" void kernel_launch(void* const* d_in, const int* in_sizes, int n_in, void* d_out, int out_size, void* d_ws, size_t ws_size, hipStream_t stream) {
    static int grid = 0;
    if (grid == 0) {
        if (n_in != 21 || ws_size < WS_END) { fprintf(stderr, "kernel_launch: unexpected inputs (%d) or workspace (%zu < %zu)\n", n_in, ws_size, (size_t)WS_END); grid = -1; return; }
        int dev = 0, cus = 0, per_cu = 0;
        (void)hipGetDevice(&dev); (void)hipDeviceGetAttribute(&cus, hipDeviceAttributeMultiprocessorCount, dev);
        if (hipFuncSetAttribute((const void*)mega_fwd, hipFuncAttributeMaxDynamicSharedMemorySize, LDS_BYTES) != hipSuccess) { fprintf(stderr, "kernel_launch: hipFuncSetAttribute failed\n"); grid = -1; return; }
        if (hipOccupancyMaxActiveBlocksPerMultiprocessor(&per_cu, (const void*)mega_fwd, 512, LDS_BYTES) != hipSuccess || per_cu < 1) { fprintf(stderr, "kernel_launch: occupancy query says %d\n", per_cu); per_cu = 1; }
        (void)hipGetLastError();
        grid = cus * 1;
        if (grid <= 0) grid = 256;
    }
    if (grid < 0) return;
    Params p{};
    const float** pp = (const float**)&p;
    for (int i = 0; i < 21; ++i) pp[i] = (const float*)d_in[i];
    p.out = (float*)d_out; p.ws = (unsigned char*)d_ws;
    if (hipMemsetAsync((unsigned char*)d_ws + WS_CTL, 0, 4096, stream) != hipSuccess) { fprintf(stderr, "kernel_launch: memset of the barrier word failed\n"); return; }
    hipError_t e = hipSuccess;
    if (N_LAUNCH_MODE == 1) { int lo = 0, hi = NPHASES; void* args[] = {&p, &lo, &hi};
        e = hipLaunchCooperativeKernel((const void*)mega_fwd, dim3(grid), dim3(512), args, LDS_BYTES, stream); }
    else { for (int ph = 0; ph < NPHASES; ++ph) hipLaunchKernelGGL(mega_fwd, dim3(grid), dim3(512), LDS_BYTES, stream, p, ph, ph + 1); e = hipGetLastError(); }
    if (e != hipSuccess) fprintf(stderr, "kernel_launch: cooperative launch failed: %s (grid %d)\n", hipGetErrorString(e), grid);
}
```
